# Optimizing an MI355X kernel written in HIP

```python
import jax, jax.numpy as jnp
from jax import lax
import numpy as np

D_MODEL = 1024
BATCH = 8
SEQ = 4096
DEPTH = 1

CHUNK = 64
D_MIX = D_MODEL
EPS = 1e-6
NEG_INF = -1e30

ATTN_WIDTH = D_MIX // 2
ATTN_HEAD_DIM = 64
ATTN_Q_HEADS = ATTN_WIDTH // ATTN_HEAD_DIM
ATTN_KV_HEADS = 2
ATTN_GROUP = ATTN_Q_HEADS // ATTN_KV_HEADS
WINDOW = 128
WINDOW_CHUNKS = WINDOW // CHUNK
ROPE_THETA = 10000.0

HGRN_WIDTH = D_MIX - ATTN_WIDTH
HGRN_EXPAND = 128
HGRN_HEADS = HGRN_WIDTH // HGRN_EXPAND
HGRN_KEY_DIM = HGRN_EXPAND
HGRN_VAL_DIM = HGRN_WIDTH // HGRN_HEADS

D_FF = 2816
FFN_RES_WEIGHT = 0.5

N_SUBLAYERS = 3
N_MOD = 3 * N_SUBLAYERS

PROJ_WIDTHS = (ATTN_WIDTH, ATTN_KV_HEADS * ATTN_HEAD_DIM, ATTN_KV_HEADS * ATTN_HEAD_DIM,
               HGRN_WIDTH, HGRN_WIDTH, HGRN_WIDTH, HGRN_WIDTH)
PROJ_OFFSETS = tuple(int(o) for o in np.cumsum(PROJ_WIDTHS)[:-1])
D_PROJ = int(sum(PROJ_WIDTHS))

kernel_name = "hybrid_swa_sink_hgrn2_macaron_block"


def _rmsnorm(x, gain):
    xf = x.astype(jnp.float32)
    inv = lax.rsqrt(jnp.mean(xf * xf, axis=-1, keepdims=True) + EPS)
    return (xf * inv * gain.astype(jnp.float32)).astype(x.dtype)


def _rope_tables(positions):
    inv_freq = 1.0 / (ROPE_THETA ** (jnp.arange(0, ATTN_HEAD_DIM, 2, dtype=jnp.float32) / ATTN_HEAD_DIM))
    ang = positions.astype(jnp.float32)[..., None] * inv_freq
    return jnp.cos(ang)[:, :, None, :], jnp.sin(ang)[:, :, None, :]


def _apply_rope(t, cos, sin):
    tf = t.astype(jnp.float32)
    t1, t2 = jnp.split(tf, 2, axis=-1)
    return jnp.concatenate([t1 * cos - t2 * sin, t2 * cos + t1 * sin], axis=-1).astype(t.dtype)


def _band(t):
    B, S, H, d = t.shape
    n_chunks = S // CHUNK
    tp = jnp.pad(t, ((0, 0), (WINDOW_CHUNKS * CHUNK, 0), (0, 0), (0, 0)))
    tp = tp.reshape(B, n_chunks + WINDOW_CHUNKS, CHUNK, H, d)
    return jnp.concatenate([tp[:, j:j + n_chunks] for j in range(WINDOW_CHUNKS + 1)], axis=2)


def _sliding_window_attention(q, k, v, sinks):
    B, S = q.shape[:2]
    n_chunks = S // CHUNK
    band = (WINDOW_CHUNKS + 1) * CHUNK
    qb = q.reshape(B, n_chunks, CHUNK, ATTN_KV_HEADS, ATTN_GROUP, ATTN_HEAD_DIM)
    kb = _band(k)
    vb = _band(v)
    scores = jnp.einsum("bnqhgd,bnkhd->bnhgqk", qb, kb,
                        preferred_element_type=jnp.float32) * (ATTN_HEAD_DIM ** -0.5)
    key_pos = (jnp.arange(n_chunks)[:, None] - WINDOW_CHUNKS) * CHUNK + jnp.arange(band)[None, :]
    valid = (key_pos >= 0)[None, :, None, None, None, :]
    scores = jnp.where(valid, scores, NEG_INF)
    sink_col = jnp.broadcast_to(
        sinks.astype(jnp.float32).reshape(1, 1, ATTN_KV_HEADS, ATTN_GROUP, 1, 1),
        scores.shape[:-1] + (1,))
    probs = jax.nn.softmax(jnp.concatenate([scores, sink_col], axis=-1), axis=-1)[..., :-1]
    out = jnp.einsum("bnhgqk,bnkhd->bnqhgd", probs.astype(v.dtype), vb)
    return out.reshape(B, S, ATTN_WIDTH)


def _hgrn2(hq, hf, hi, hg, lower_bound, gnorm_gain):
    B, S = hq.shape[:2]
    n_chunks = S // CHUNK
    q = jax.nn.silu(hq.astype(jnp.float32)) * (HGRN_KEY_DIM ** -0.5)
    f = lower_bound + (1.0 - lower_bound) * jax.nn.sigmoid(hf.astype(jnp.float32))
    log_f = jnp.log(f)
    k = 1.0 - f
    v = hi.astype(jnp.float32)

    def to_chunks(t, d):
        return t.reshape(B, n_chunks, CHUNK, HGRN_HEADS, d).transpose(1, 0, 3, 2, 4)

    qc = to_chunks(q, HGRN_KEY_DIM)
    kc = to_chunks(k, HGRN_KEY_DIM)
    gc = to_chunks(log_f, HGRN_KEY_DIM)
    vc = to_chunks(v, HGRN_VAL_DIM)
    causal = jnp.tril(jnp.ones((CHUNK, CHUNK), dtype=bool))[:, :, None]

    def step(state, inp):
        q_c, k_c, g_c, v_c = inp
        b = jnp.cumsum(g_c, axis=2)
        o_inter = jnp.einsum("bhtd,bhde->bhte", q_c * jnp.exp(b), state)
        diff = b[:, :, :, None, :] - b[:, :, None, :, :]
        decay = jnp.exp(jnp.where(causal, diff, -jnp.inf))
        scores = jnp.einsum("bhtd,bhsd,bhtsd->bhts", q_c, k_c, decay)
        o_intra = jnp.einsum("bhts,bhse->bhte", scores, v_c)
        b_last = b[:, :, -1:, :]
        new_state = (jnp.exp(b_last[:, :, 0, :])[..., None] * state
                     + jnp.einsum("bhsd,bhse->bhde", k_c * jnp.exp(b_last - b), v_c))
        return new_state, o_inter + o_intra

    state0 = jnp.zeros((B, HGRN_HEADS, HGRN_KEY_DIM, HGRN_VAL_DIM), jnp.float32)
    _, oc = lax.scan(step, state0, (qc, kc, gc, vc))
    o = oc.transpose(1, 0, 3, 2, 4).reshape(B, S, HGRN_HEADS, HGRN_VAL_DIM)
    o = o * lax.rsqrt(jnp.mean(o * o, axis=-1, keepdims=True) + EPS) * gnorm_gain.astype(jnp.float32)
    g = jax.nn.silu(hg.astype(jnp.float32)).reshape(B, S, HGRN_HEADS, HGRN_VAL_DIM)
    return (o * g).reshape(B, S, HGRN_WIDTH).astype(hq.dtype)


def _swiglu(h, w_in, w_out):
    gate, up = jnp.split(h @ w_in, 2, axis=-1)
    return (jax.nn.silu(gate) * up) @ w_out


def _token_mixer(h, w_in, w_out, sinks, lower_bound, gnorm_gain, cos, sin):
    B, S = h.shape[:2]
    aq, ak, av, hq, hf, hi, hg = jnp.split(h @ w_in, PROJ_OFFSETS, axis=-1)
    aq = _apply_rope(aq.reshape(B, S, ATTN_Q_HEADS, ATTN_HEAD_DIM), cos, sin)
    ak = _apply_rope(ak.reshape(B, S, ATTN_KV_HEADS, ATTN_HEAD_DIM), cos, sin)
    av = av.reshape(B, S, ATTN_KV_HEADS, ATTN_HEAD_DIM)
    attn = _sliding_window_attention(aq, ak, av, sinks)
    rec = _hgrn2(hq, hf, hi, hg, lower_bound, gnorm_gain)
    return jnp.concatenate([attn, rec], axis=-1) @ w_out


def setup_inputs(seed: int = 0) -> dict:
    key = jax.random.key(seed)
    ks = jax.random.split(key, 16)
    f32 = jnp.float32
    x = jax.random.normal(ks[0], (BATCH, SEQ, D_MODEL), f32)
    c = jax.random.normal(ks[1], (BATCH, D_MODEL), f32)
    offset = jax.random.randint(ks[2], (BATCH, 1), 0, 64, dtype=jnp.int32) * CHUNK
    positions = (offset + jnp.arange(SEQ, dtype=jnp.int32)[None, :]).astype(jnp.int32)
    w_cond = jax.random.normal(ks[3], (DEPTH, D_MODEL, N_MOD * D_MODEL), f32) * (0.5 * D_MODEL ** -0.5)
    b_cond = jax.random.normal(ks[4], (DEPTH, N_MOD * D_MODEL), f32) * 0.01
    norm_pre = 1.0 + 0.02 * jax.random.normal(ks[5], (DEPTH, N_SUBLAYERS, D_MODEL), f32)
    norm_post = 1.0 + 0.02 * jax.random.normal(ks[6], (DEPTH, N_SUBLAYERS, D_MODEL), f32)
    ffn_w_in = jax.random.normal(ks[7], (DEPTH, 2, D_MODEL, 2 * D_FF), f32) * (D_MODEL ** -0.5)
    ffn_w_out = jax.random.normal(ks[8], (DEPTH, 2, D_FF, D_MODEL), f32) * (D_FF ** -0.5)
    w_mix_in = jax.random.normal(ks[9], (DEPTH, D_MODEL, D_PROJ), f32) * (D_MODEL ** -0.5)
    w_mix_out = jax.random.normal(ks[10], (DEPTH, D_MIX, D_MODEL), f32) * (D_MIX ** -0.5)
    attn_sinks = jax.random.normal(ks[11], (DEPTH, ATTN_Q_HEADS), f32)
    hgrn_lb_logits = 1.0 + 0.1 * jax.random.normal(ks[12], (DEPTH + 1, HGRN_WIDTH), f32)
    hgrn_gnorm = 1.0 + 0.02 * jax.random.normal(ks[13], (DEPTH, HGRN_VAL_DIM), f32)
    return {"x": x, "c": c, "positions": positions, "w_cond": w_cond, "b_cond": b_cond,
            "norm_pre": norm_pre, "norm_post": norm_post, "ffn_w_in": ffn_w_in,
            "ffn_w_out": ffn_w_out, "w_mix_in": w_mix_in, "w_mix_out": w_mix_out,
            "attn_sinks": attn_sinks, "hgrn_lb_logits": hgrn_lb_logits, "hgrn_gnorm": hgrn_gnorm}


def reference(x, c, positions, w_cond, b_cond, norm_pre, norm_post, ffn_w_in, ffn_w_out,
              w_mix_in, w_mix_out, attn_sinks, hgrn_lb_logits, hgrn_gnorm):
    cos, sin = _rope_tables(positions)
    lower_bounds = jnp.cumsum(jax.nn.softmax(hgrn_lb_logits.astype(jnp.float32), axis=0), axis=0)
    c_act = jax.nn.silu(c)
    for layer in range(DEPTH):
        mod = (c_act @ w_cond[layer] + b_cond[layer])[:, None, :]
        sh1, sc1, gt1, sh2, sc2, gt2, sh3, sc3, gt3 = jnp.split(mod, N_MOD, axis=-1)
        h = _rmsnorm(x, norm_pre[layer, 0]) * (1.0 + sc1) + sh1
        y = _swiglu(h, ffn_w_in[layer, 0], ffn_w_out[layer, 0])
        x = x + FFN_RES_WEIGHT * gt1 * _rmsnorm(y, norm_post[layer, 0])
        h = _rmsnorm(x, norm_pre[layer, 1]) * (1.0 + sc2) + sh2
        y = _token_mixer(h, w_mix_in[layer], w_mix_out[layer], attn_sinks[layer],
                         lower_bounds[layer], hgrn_gnorm[layer], cos, sin)
        x = x + gt2 * _rmsnorm(y, norm_post[layer, 1])
        h = _rmsnorm(x, norm_pre[layer, 2]) * (1.0 + sc3) + sh3
        y = _swiglu(h, ffn_w_in[layer, 1], ffn_w_out[layer, 1])
        x = x + FFN_RES_WEIGHT * gt3 * _rmsnorm(y, norm_post[layer, 2])
    return x
```

```cpp
#include <hip/hip_runtime.h>
#include <cstdio>
#include <cstdint>
namespace pg8 {
#define PG8_LAS __attribute__((address_space(3)))
typedef unsigned short bf16_t;
typedef short bf16x8 __attribute__((ext_vector_type(8)));
typedef float f32x4 __attribute__((ext_vector_type(4)));
typedef unsigned u32x4 __attribute__((ext_vector_type(4)));
constexpr int BM = 256, BK = 64, HALF = 128, HTB = HALF * BK * 2  , STAGE_BYTES = 8 * HTB, NXCD = 8, WGM = 8;

__host__ __device__ __forceinline__ int lds_byte(int r, int c) { const int st = (r >> 4) * 2 + (c >> 5), rr = r & 15, cc = c & 31, ob = rr * 64 + cc * 2; return st * 1024 + (ob ^ (((ob >> 9) & 1) << 5)); }
__host__ __device__ __forceinline__ void stage_rc(int b, int& R, int& C) { const int st = b / 1024, sb = b % 1024, swz = sb ^ (((sb >> 9) & 1) << 5); R = (st >> 1) * 16 + swz / 64; C = (st & 1) * 32 + (swz % 64) / 2; }
__host__ __device__ __forceinline__ int perm32(int rho) { const int n = rho >> 4, i = rho & 15; return 8 * (i >> 2) + 4 * n + (i & 3); }

struct Unit { int pm, pn; };
struct Gemm { const bf16_t* A; const bf16_t* Bt; int M, N, K; };

struct StaticOrder {
    int nM, nN, nwg, G, c;
    __host__ __device__ void init(int M, int N, int G_, int c_) { nM = M / BM; nN = N / BM; nwg = nM * nN; G = G_; c = c_; }
    __host__ __device__ bool next(int i, Unit& u) const {
        const long L = (long)i * G + c; if (L >= nwg) return false;
        int wgid = (int)L; { const int q = nwg / NXCD, r = nwg % NXCD, xcd = wgid % NXCD, off = wgid / NXCD; wgid = (xcd < r ? xcd * (q + 1) : r * (q + 1) + (xcd - r) * q) + off; }
        const int nig = WGM * nN, gid = wgid / nig, fm = gid * WGM, gsz = (nM - fm) < WGM ? (nM - fm) : WGM;
        u.pm = fm + ((wgid % nig) % gsz); u.pn = (wgid % nig) / gsz; return true;
    }
    __device__ __forceinline__ void a_ready(const Unit&) const {}
    __device__ __forceinline__ void done(const Unit&) const {}
};

__device__ __forceinline__ unsigned cvt_pk_bf16(float lo, float hi) { unsigned r; asm volatile("v_cvt_pk_bf16_f32 %0, %1, %2" : "=v"(r) : "v"(lo), "v"(hi)); return r; }
typedef float f32x2 __attribute__((ext_vector_type(2)));
constexpr float LOG2E = 1.4426950408889634f;
__device__ __forceinline__ float fast_sigmoid(float x) { return __builtin_amdgcn_rcpf(1.0f + __builtin_amdgcn_exp2f(-LOG2E * x)); }
__device__ __forceinline__ float fast_silu(float x) { return x * fast_sigmoid(x); }
__device__ __forceinline__ u32x4 pack8(const f32x4 a, const f32x4 b) { u32x4 w; w.x = cvt_pk_bf16(a[0], a[1]); w.y = cvt_pk_bf16(a[2], a[3]); w.z = cvt_pk_bf16(b[0], b[1]); w.w = cvt_pk_bf16(b[2], b[3]); return w; }

struct EpiF32 {
    static constexpr bool PERM = false, AFTER_DRAIN = false;
    float* C; int ldc;
    __device__ __forceinline__ void operator()(const f32x4 (&acc)[2][2][4][2], const Unit& u, int wr, int wc, int fr, int fq) const {
        const int row0 = u.pm * BM + wr * 64 + fr, col0 = u.pn * BM + wc * 32 + 4 * fq;
#pragma unroll
        for (int ai = 0; ai < 2; ++ai)
#pragma unroll
            for (int m = 0; m < 4; ++m) { float* rowp = C + (size_t)(row0 + ai * HALF + m * 16) * ldc + col0;
#pragma unroll
                for (int bj = 0; bj < 2; ++bj)
#pragma unroll
                    for (int n = 0; n < 2; ++n) *(f32x4*)(rowp + bj * HALF + n * 16) = acc[ai][bj][m][n]; }
    }
};

struct EpiSwiGLU {
    static constexpr bool PERM = true, AFTER_DRAIN = false;
    bf16_t* O; int ldc;
    __device__ __forceinline__ void operator()(const f32x4 (&acc)[2][2][4][2], const Unit& u, int wr, int wc, int fr, int fq) const {
        const int row0 = u.pm * BM + wr * 64 + fr, col0 = u.pn * HALF + wc * 32 + 8 * fq;
#pragma unroll
        for (int ai = 0; ai < 2; ++ai)
#pragma unroll
            for (int m = 0; m < 4; ++m) {
                bf16_t* p = O + (size_t)(row0 + ai * HALF + m * 16) * ldc + col0;
                f32x4 r0, r1;
#pragma unroll
                for (int i = 0; i < 4; ++i) { r0[i] = fast_silu(acc[ai][0][m][0][i]) * acc[ai][1][m][0][i]; r1[i] = fast_silu(acc[ai][0][m][1][i]) * acc[ai][1][m][1][i]; }
                *(u32x4*)p = pack8(r0, r1);
            }
    }
};

template <int CTRL> __device__ __forceinline__ float dpp_mov0(float x) { return __builtin_bit_cast(float, __builtin_amdgcn_update_dpp(0, __builtin_bit_cast(int, x), CTRL, 0xf, 0xf, false)); }
__device__ __forceinline__ float row_incl_scan(float x) { x += dpp_mov0<0x111>(x); x += dpp_mov0<0x112>(x); x += dpp_mov0<0x114>(x); x += dpp_mov0<0x118>(x); return x; }

struct EpiMix {
    static constexpr bool PERM = true, AFTER_DRAIN = false;
    bf16_t *Q, *Kb, *Vb, *QT, *KH, *VH, *GH; float* EBL; const float* cosT; const float* sinT; const float* lbl;
    __device__ __forceinline__ void operator()(const f32x4 (&acc)[2][2][4][2], const Unit& u, int wr, int wc, int fr, int fq) const {
        const int pn = u.pn, row0 = u.pm * BM + wr * 64 + fr;
        if (pn <= 2) {
            if (pn < 2 || wc < 2) {
                const bool isq = pn < 2;
                bf16_t* base = isq ? Q : Kb; const int ld = isq ? 512 : 128; const int hcol = (isq ? (4 * pn + wc) : wc) * 64 + 8 * fq;
                const float sc = isq ? (0.125f * LOG2E) : 1.0f;
#pragma unroll
                for (int ai = 0; ai < 2; ++ai)
#pragma unroll
                    for (int m = 0; m < 4; ++m) {
                        const int row = row0 + ai * HALF + m * 16;
                        const f32x4 c0 = *(const f32x4*)(cosT + (size_t)row * 32 + 8 * fq), c1 = *(const f32x4*)(cosT + (size_t)row * 32 + 8 * fq + 4);
                        const f32x4 s0 = *(const f32x4*)(sinT + (size_t)row * 32 + 8 * fq), s1 = *(const f32x4*)(sinT + (size_t)row * 32 + 8 * fq + 4);
                        const f32x4 a0 = acc[ai][0][m][0], a1 = acc[ai][0][m][1], b0 = acc[ai][1][m][0], b1 = acc[ai][1][m][1];
                        const f32x4 o10 = (a0 * c0 - b0 * s0) * sc, o11 = (a1 * c1 - b1 * s1) * sc, o20 = (b0 * c0 + a0 * s0) * sc, o21 = (b1 * c1 + a1 * s1) * sc;
                        bf16_t* p = base + (size_t)row * ld + hcol;
                        *(u32x4*)p = pack8(o10, o11); *(u32x4*)(p + 32) = pack8(o20, o21);
                        asm volatile("" ::: "memory");
                    }
            } else {
#pragma unroll
                for (int ai = 0; ai < 2; ++ai)
#pragma unroll
                    for (int m = 0; m < 4; ++m) {
                        const int row = row0 + ai * HALF + m * 16;
#pragma unroll
                        for (int bj = 0; bj < 2; ++bj) *(u32x4*)(Vb + (size_t)row * 128 + 64 * bj + 32 * (wc - 2) + 8 * fq) = pack8(acc[ai][bj][m][0], acc[ai][bj][m][1]);
                    }
            }
        } else if (pn <= 6) {
            const int hh = pn - 3, dcol = hh * 128 + wc * 32 + 8 * fq;
            float lb[2][4], omlb[2][4];
#pragma unroll
            for (int n = 0; n < 2; ++n) { const f32x4 l0 = *(const f32x4*)(lbl + dcol + 4 * n), l1 = *(const f32x4*)(lbl + 512 + dcol + 4 * n);
#pragma unroll
                for (int i = 0; i < 4; ++i) { const float e = __expf(l1[i] - l0[i]); lb[n][i] = 1.0f / (1.0f + e); omlb[n][i] = e / (1.0f + e); } }
#pragma unroll
            for (int ai = 0; ai < 2; ++ai) {
                float b2[4][2][4];
#pragma unroll
                for (int m = 0; m < 4; ++m)
#pragma unroll
                    for (int n = 0; n < 2; ++n)
#pragma unroll
                        for (int i = 0; i < 4; ++i) { const float hf = __builtin_fminf(__builtin_fmaxf(acc[ai][1][m][n][i], -30.f), 30.f);
                            const float f = lb[n][i] + omlb[n][i] * fast_sigmoid(hf); b2[m][n][i] = __builtin_amdgcn_logf(f); }
#pragma unroll
                for (int n = 0; n < 2; ++n)
#pragma unroll
                    for (int i = 0; i < 4; ++i) { float carry = 0.f;
#pragma unroll
                        for (int m = 0; m < 4; ++m) { const float P = row_incl_scan(b2[m][n][i]); const float T = __shfl(P, (int)((threadIdx.x & 63u) | 15u)); b2[m][n][i] = P + carry; carry += T; } }
#pragma unroll
                for (int m = 0; m < 4; ++m) {
                    const int row = row0 + ai * HALF + m * 16;
                    f32x4 qo[2], ko[2], eb[2];
#pragma unroll
                    for (int n = 0; n < 2; ++n)
#pragma unroll
                        for (int i = 0; i < 4; ++i) { const float hq = acc[ai][0][m][n][i]; float hf = acc[ai][1][m][n][i]; asm volatile("" : "+v"(hf)); hf = __builtin_fminf(__builtin_fmaxf(hf, -30.f), 30.f);
                            const float e = __builtin_amdgcn_exp2f(-LOG2E * hf), r = __builtin_amdgcn_rcpf(1.0f + e), kk = omlb[n][i] * (e * r);
                            const float q = fast_silu(hq) * 0.08838834764831845f, bb = b2[m][n][i], eb_ = __builtin_amdgcn_exp2f(bb);
                            qo[n][i] = q * eb_; ko[n][i] = kk * __builtin_amdgcn_exp2f(-bb); eb[n][i] = eb_; }
                    *(u32x4*)(QT + (size_t)row * 512 + dcol) = pack8(qo[0], qo[1]);
                    *(u32x4*)(KH + (size_t)row * 512 + dcol) = pack8(ko[0], ko[1]);
                    if (m == 3 && fr == 15) { float* ep = EBL + (size_t)(u.pm * 4 + 2 * ai + wr) * 512 + dcol; *(f32x4*)ep = eb[0]; *(f32x4*)(ep + 4) = eb[1]; }
                    asm volatile("" ::: "memory");
                }
            }
        } else {
            const bool isg = pn >= 9; bf16_t* base = isg ? GH : VH; const int tcol = (pn - (isg ? 9 : 7)) * 256 + wc * 32 + 8 * fq;
#pragma unroll
            for (int ai = 0; ai < 2; ++ai)
#pragma unroll
                for (int m = 0; m < 4; ++m) {
                    const int row = row0 + ai * HALF + m * 16;
#pragma unroll
                    for (int bj = 0; bj < 2; ++bj) { f32x4 v0 = acc[ai][bj][m][0], v1 = acc[ai][bj][m][1];
                        if (isg) {
#pragma unroll
                            for (int i = 0; i < 4; ++i) { v0[i] = fast_silu(v0[i]); v1[i] = fast_silu(v1[i]); } }
                        *(u32x4*)(base + (size_t)row * 512 + tcol + bj * HALF) = pack8(v0, v1); }
                }
        }
    }
};
template <class Epi, class Sched, bool ALIGN_EPI = false, bool SP2 = false>
__device__ __forceinline__ void gemm_phase(PG8_LAS unsigned char* lds, const Gemm g, const Sched& S, const Epi& E) {
    const int tid = threadIdx.x, wid = __builtin_amdgcn_readfirstlane(tid >> 6), lane = tid & 63, wr = wid >> 2, wc = wid & 3, fr = lane & 15, fq = lane >> 4;
    const int K = g.K, nt = K / BK;
    unsigned voffA[2], voffB[2];
#pragma unroll
    for (int i = 0; i < 2; ++i) { int R, C; stage_rc(tid * 16 + i * 8192, R, C); const int Rb = Epi::PERM ? ((R & ~31) + perm32(R & 31)) : R;
        voffA[i] = (unsigned)(R * K + C) * 2u; voffB[i] = (unsigned)(Rb * K + C) * 2u; }
    const size_t kstep = (size_t)(BK * 2);
    const size_t hstep = (size_t)HALF * K * 2;
    const size_t tstep = 2 * hstep;
    const unsigned ldsw = (unsigned)wid * 1024u;
    const int aoff = lds_byte(wr * 64 + fr, fq * 8), boff = lds_byte(wc * 32 + fr, fq * 8);
#define PG8_SA(b, h) (((b) * 2 + (h)) * HTB)
#define PG8_SB(b, h) ((4 + (b) * 2 + (h)) * HTB)
#define PG8_STAGE(bufoff, gbase, voff) do { _Pragma("unroll") for (int _i = 0; _i < 2; ++_i) \
        __builtin_amdgcn_global_load_lds((const unsigned*)((const char*)(gbase) + (voff)[_i]), (PG8_LAS unsigned*)(lds + (bufoff) + ldsw + _i * 8192), 16, 0, 0); } while (0)
#define PG8_LDA(dst, b, h) do { _Pragma("unroll") for (int m = 0; m < 4; ++m) _Pragma("unroll") for (int k = 0; k < 2; ++k) dst[m][k] = *(const PG8_LAS bf16x8*)(lds + PG8_SA(b, h) + aoff + m * 2048 + k * 1024); } while (0)
#define PG8_LDB(dst, b, h) do { _Pragma("unroll") for (int n = 0; n < 2; ++n) _Pragma("unroll") for (int k = 0; k < 2; ++k) dst[n][k] = *(const PG8_LAS bf16x8*)(lds + PG8_SB(b, h) + boff + n * 2048 + k * 1024); } while (0)
#define PG8_MMA(ai, bj, At, Bt) do { __builtin_amdgcn_s_setprio(1); _Pragma("unroll") for (int m = 0; m < 4; ++m) _Pragma("unroll") for (int n = 0; n < 2; ++n) _Pragma("unroll") for (int k = 0; k < 2; ++k) \
        acc[ai][bj][m][n] = __builtin_amdgcn_mfma_f32_16x16x32_bf16(Bt[n][k], At[m][k], acc[ai][bj][m][n], 0, 0, 0); __builtin_amdgcn_s_setprio(0); } while (0)
#define PG8_WAIT_V(n) asm volatile("s_waitcnt vmcnt(" #n ")" ::: "memory")
#define PG8_WAIT_L(n) asm volatile("s_waitcnt lgkmcnt(" #n ")" ::: "memory")
#define PG8_BAR __builtin_amdgcn_s_barrier()
#define PG8_SCHED __builtin_amdgcn_sched_barrier(0)
    Unit cur, nxt; int ui = 0;
    if (!S.next(0, cur)) return;
    f32x4 acc[2][2][4][2];
#pragma unroll
    for (int a = 0; a < 2; ++a)
#pragma unroll
        for (int b = 0; b < 2; ++b)
#pragma unroll
            for (int m = 0; m < 4; ++m)
#pragma unroll
                for (int n = 0; n < 2; ++n) acc[a][b][m][n] = (f32x4){0.f, 0.f, 0.f, 0.f};
    bf16x8 At[4][2], B0[2][2], B1[2][2];
    const char* cA = (const char*)g.A + (size_t)cur.pm * tstep; const char* cB = (const char*)g.Bt + (size_t)cur.pn * tstep;
    S.a_ready(cur);
    if constexpr (SP2) {
        PG8_STAGE(PG8_SB(0, 0), cB, voffB); PG8_STAGE(PG8_SB(0, 1), cB + hstep, voffB); PG8_STAGE(PG8_SA(0, 0), cA, voffA); PG8_STAGE(PG8_SA(0, 1), cA + hstep, voffA);
        if (wr == 1) PG8_BAR;
        PG8_WAIT_V(2); PG8_BAR;
        PG8_STAGE(PG8_SB(1, 0), cB + kstep, voffB); PG8_STAGE(PG8_SA(1, 0), cA + kstep, voffA); PG8_STAGE(PG8_SB(1, 1), cB + hstep + kstep, voffB);
        PG8_WAIT_V(6); PG8_BAR;
    } else {
        PG8_STAGE(PG8_SB(0, 0), cB, voffB); PG8_STAGE(PG8_SA(0, 0), cA, voffA); PG8_STAGE(PG8_SB(0, 1), cB + hstep, voffB); PG8_STAGE(PG8_SA(0, 1), cA + hstep, voffA);
        if (wr == 1) PG8_BAR;
        PG8_WAIT_V(4); PG8_BAR;
        PG8_STAGE(PG8_SB(1, 0), cB + kstep, voffB); PG8_STAGE(PG8_SA(1, 0), cA + kstep, voffA); PG8_STAGE(PG8_SB(1, 1), cB + hstep + kstep, voffB);
        PG8_WAIT_V(6); PG8_BAR;
    }
    for (;;) {
        const bool has_next = S.next(ui + 1, nxt);
        const char* nA = has_next ? (const char*)g.A + (size_t)nxt.pm * tstep : cA; const char* nB = has_next ? (const char*)g.Bt + (size_t)nxt.pn * tstep : cB;
        for (int t = 0; t < nt; t += 2) {
            const bool last = (t == nt - 2);
            const char* a1 = cA + (size_t)(t + 1) * kstep;
            const char* a2 = last ? nA : cA + (size_t)(t + 2) * kstep; const char* b2 = last ? nB : cB + (size_t)(t + 2) * kstep;
            const char* a3 = a2 + kstep; const char* b3 = b2 + kstep;
            if (last && has_next) S.a_ready(nxt);
            if constexpr (SP2) {
            PG8_LDB(B0, 0, 0); PG8_LDB(B1, 0, 1); PG8_SCHED; PG8_LDA(At, 0, 0); PG8_STAGE(PG8_SA(1, 1), a1 + hstep, voffA);
            PG8_WAIT_V(8); PG8_WAIT_L(0); PG8_BAR; PG8_MMA(0, 0, At, B0); PG8_MMA(0, 1, At, B1); PG8_BAR; PG8_SCHED;
            PG8_LDA(At, 0, 1); PG8_STAGE(PG8_SB(0, 0), b2, voffB); PG8_STAGE(PG8_SB(0, 1), b2 + hstep, voffB); PG8_STAGE(PG8_SA(0, 0), a2, voffA);
            PG8_WAIT_V(8); PG8_WAIT_L(0); PG8_BAR; PG8_MMA(1, 0, At, B0); PG8_MMA(1, 1, At, B1); PG8_BAR; PG8_SCHED;
            PG8_LDB(B0, 1, 0); PG8_LDB(B1, 1, 1); PG8_SCHED; PG8_LDA(At, 1, 0); PG8_STAGE(PG8_SA(0, 1), a2 + hstep, voffA);
            PG8_WAIT_V(8); PG8_WAIT_L(0); PG8_BAR; PG8_MMA(0, 0, At, B0); PG8_MMA(0, 1, At, B1); PG8_BAR; PG8_SCHED;
            PG8_LDA(At, 1, 1); PG8_STAGE(PG8_SB(1, 0), b3, voffB); PG8_STAGE(PG8_SB(1, 1), b3 + hstep, voffB); PG8_STAGE(PG8_SA(1, 0), a3, voffA);
            PG8_WAIT_V(8); PG8_WAIT_L(0); PG8_BAR; PG8_MMA(1, 0, At, B0); PG8_MMA(1, 1, At, B1); PG8_BAR; PG8_SCHED;
            } else {
            PG8_LDB(B0, 0, 0); PG8_SCHED; PG8_LDA(At, 0, 0); PG8_STAGE(PG8_SA(1, 1), a1 + hstep, voffA);
            PG8_WAIT_L(8); PG8_BAR; PG8_WAIT_L(0); PG8_MMA(0, 0, At, B0); PG8_BAR; PG8_SCHED;
            PG8_LDB(B1, 0, 1); PG8_STAGE(PG8_SB(0, 0), b2, voffB);
            PG8_BAR; PG8_WAIT_L(0); PG8_MMA(0, 1, At, B1); PG8_BAR;
            PG8_LDA(At, 0, 1); PG8_STAGE(PG8_SA(0, 0), a2, voffA);
            PG8_BAR; PG8_WAIT_L(0); PG8_MMA(1, 0, At, B0); PG8_BAR; PG8_SCHED;
            PG8_STAGE(PG8_SB(0, 1), b2 + hstep, voffB);
            PG8_WAIT_V(6); PG8_BAR; PG8_MMA(1, 1, At, B1); PG8_BAR;
            PG8_LDB(B0, 1, 0); PG8_SCHED; PG8_LDA(At, 1, 0); PG8_STAGE(PG8_SA(0, 1), a2 + hstep, voffA);
            PG8_WAIT_L(8); PG8_BAR; PG8_WAIT_L(0); PG8_MMA(0, 0, At, B0); PG8_BAR; PG8_SCHED;
            PG8_LDB(B1, 1, 1); PG8_STAGE(PG8_SB(1, 0), b3, voffB);
            PG8_BAR; PG8_WAIT_L(0); PG8_MMA(0, 1, At, B1); PG8_BAR;
            PG8_LDA(At, 1, 1); PG8_STAGE(PG8_SA(1, 0), a3, voffA);
            PG8_BAR; PG8_WAIT_L(0); PG8_MMA(1, 0, At, B0); PG8_BAR; PG8_SCHED;
            PG8_STAGE(PG8_SB(1, 1), b3 + hstep, voffB);
            PG8_WAIT_V(6); PG8_BAR; PG8_MMA(1, 1, At, B1); PG8_BAR;
            }
        }
        if constexpr (ALIGN_EPI) { if (wr == 0) PG8_BAR; }
        if constexpr (!Epi::AFTER_DRAIN) { E(acc, cur, wr, wc, fr, fq); S.done(cur); }
        if (!has_next) break;
#pragma unroll
        for (int a = 0; a < 2; ++a)
#pragma unroll
            for (int b = 0; b < 2; ++b)
#pragma unroll
                for (int m = 0; m < 4; ++m)
#pragma unroll
                    for (int n = 0; n < 2; ++n) acc[a][b][m][n] = (f32x4){0.f, 0.f, 0.f, 0.f};
        cur = nxt; cA = nA; cB = nB; ++ui;
        if constexpr (ALIGN_EPI) { if (wr == 1) PG8_BAR; }
    }
    PG8_WAIT_V(0);
    if constexpr (!ALIGN_EPI) { if (wr == 0) PG8_BAR; }
    PG8_BAR;
    if constexpr (Epi::AFTER_DRAIN) { E.fused(acc, cur, wr, wc, fr, fq, lds, wid, lane); S.done(cur); }
#undef PG8_SA
#undef PG8_SB
#undef PG8_STAGE
#undef PG8_LDA
#undef PG8_LDB
#undef PG8_MMA
#undef PG8_WAIT_V
#undef PG8_WAIT_L
#undef PG8_BAR
#undef PG8_SCHED
}
}
#define GAS __attribute__((address_space(1)))
#define LAS __attribute__((address_space(3)))
typedef unsigned short bf16;
typedef unsigned v4u __attribute__((ext_vector_type(4)));
typedef float f32x4 __attribute__((ext_vector_type(4)));
typedef short bf16x8 __attribute__((ext_vector_type(8)));
typedef GAS unsigned gu32;
typedef GAS unsigned long long gu64;
#define RLX_AGENT __ATOMIC_RELAXED, __HIP_MEMORY_SCOPE_AGENT
#define LDS_WAIT() asm volatile("s_waitcnt lgkmcnt(0)" ::: "memory")
#define VM_WAIT() asm volatile("s_waitcnt vmcnt(0)" ::: "memory")
__device__ __forceinline__ unsigned long long rt() { return __builtin_amdgcn_s_memrealtime(); }
__device__ __forceinline__ unsigned f2bf(float f) { unsigned u = __builtin_bit_cast(unsigned, f); return (u + 0x7fffu + ((u >> 16) & 1u)) >> 16; }
__device__ __forceinline__ unsigned pk2(float lo, float hi) { return f2bf(lo) | (f2bf(hi) << 16); }

#define XB_TMO      128
#define XB_XCNT(j)  (256  + 64 * (j))
#define XB_XSUB(j)  (1280 + 64 * (j))
#define XB_XGEN(j)  (2304 + 64 * (j))
#define XB_TOP      3328
#define XB_TOPGEN   3392
#define XCD_BAR_WORDS 3456
#define XB_SPIN_CAP (1u << 18)

__device__ __forceinline__ unsigned xb_ld(unsigned* p)              { return __hip_atomic_load(p, __ATOMIC_RELAXED, __HIP_MEMORY_SCOPE_AGENT); }
__device__ __forceinline__ unsigned xb_add(unsigned* p, unsigned v) { return __hip_atomic_fetch_add(p, v, __ATOMIC_RELAXED, __HIP_MEMORY_SCOPE_AGENT); }
__device__ __forceinline__ unsigned xb_xcc_id() { return (unsigned)__builtin_amdgcn_s_getreg((3 << 11) | 20) & 0xFu; }
#define XB_SPIN(cond, bar) do { unsigned _sp = 0; while (cond) { __builtin_amdgcn_s_sleep(1); \
    if ((++_sp & 255u) == 0u) { if (xb_ld(&(bar)[XB_TMO])) break; if (_sp > XB_SPIN_CAP) { atomicAdd(&(bar)[XB_TMO], 1u); break; } } } } while (0)

struct XcdBarrier {
    unsigned* bar; unsigned x;
    volatile LAS unsigned* st;
};

__device__ __forceinline__ XcdBarrier xcd_barrier_post(unsigned* bar, volatile LAS unsigned* st) {
    XcdBarrier b; b.bar = bar; b.x = xb_xcc_id(); b.st = st;
    if (threadIdx.x == 0) (void)xb_add(&bar[XB_XCNT(b.x)], 1u);
    return b;
}
__device__ __forceinline__ void xcd_barrier_complete(unsigned* bar, unsigned x, unsigned& nloc, unsigned& nx) {
    const unsigned G = gridDim.x * gridDim.y * gridDim.z;
    unsigned sum, cnt, mine, sp = 0u;
    for (;;) {
        sum = 0u; cnt = 0u; mine = 0u;
#pragma unroll
        for (unsigned j = 0; j < 16; ++j) { const unsigned c = xb_ld(&bar[XB_XCNT(j)]); sum += c; cnt += (c > 0u) ? 1u : 0u; mine = (j == x) ? c : mine; }
        if (sum == G) break;
        __builtin_amdgcn_s_sleep(1);
        if ((++sp & 255u) == 0u) { if (xb_ld(&bar[XB_TMO])) break; if (sp > XB_SPIN_CAP) { atomicAdd(&bar[XB_TMO], 1u); break; } }
    }
    nloc = mine > 0u ? mine : 1u; nx = cnt > 0u ? cnt : 1u;
}

__device__ __forceinline__ void xcd_barrier(const XcdBarrier& b) {
    asm volatile("s_waitcnt vmcnt(0)" ::: "memory");
    __syncthreads();
    if (threadIdx.x == 0) {
        unsigned* bar = b.bar;
        __builtin_amdgcn_s_waitcnt(0);
        unsigned nloc = b.st[0], nx = b.st[1];
        if (nloc == 0u) { xcd_barrier_complete(bar, b.x, nloc, nx); b.st[0] = nloc; b.st[1] = nx; }
        const unsigned old = xb_add(&bar[XB_XSUB(b.x)], 1u);
        const unsigned gen = old / nloc;
        if (old + 1u == (gen + 1u) * nloc) {
            __builtin_amdgcn_fence(__ATOMIC_RELEASE, "agent");
            asm volatile("s_waitcnt vmcnt(0)" ::: "memory");
            const unsigned og = xb_add(&bar[XB_TOP], 1u);
            const unsigned tg = og / nx;
            if (og + 1u == (tg + 1u) * nx) xb_add(&bar[XB_TOPGEN], 1u);
            else XB_SPIN(xb_ld(&bar[XB_TOPGEN]) == tg, bar);
            __builtin_amdgcn_fence(__ATOMIC_ACQUIRE, "agent");
            xb_add(&bar[XB_XGEN(b.x)], 1u);
            asm volatile("s_waitcnt vmcnt(0)" ::: "memory");
        } else {
            XB_SPIN(xb_ld(&bar[XB_XGEN(b.x)]) == gen, bar);
            __builtin_amdgcn_fence(__ATOMIC_ACQUIRE, "agent");
            asm volatile("s_waitcnt vmcnt(0)" ::: "memory");
        }
    }
    __syncthreads();
}

constexpr int NWAVES = 8;
constexpr int BATCH = 8, SEQ = 4096, D = 1024, M = BATCH * SEQ, FF = 2816, NPROJ = 2816, NMOD = 9 * D, CHUNK = 64;
constexpr float EPS = 1e-6f;
constexpr size_t MiB = 1u << 20;
constexpr size_t WS_CTL = 0, CTL_ZERO_BYTES = 1 * MiB;
constexpr size_t WS_W1A = 2 * MiB, WS_W1B = 13 * MiB, WS_W2A = 24 * MiB, WS_W2B = 30 * MiB, WS_WMI = 36 * MiB, WS_WMO = 42 * MiB;
constexpr size_t WS_MODP = 44 * MiB, WS_MOD = 47 * MiB, WS_COS = 48 * MiB, WS_SIN = 52 * MiB, WS_EBL = 56 * MiB;
constexpr size_t WS_H = 64 * MiB;
constexpr size_t WS_U = 128 * MiB;
constexpr size_t WS_Q = 128 * MiB, WS_K = 160 * MiB, WS_V = 168 * MiB, WS_QT = 176 * MiB, WS_KH = 208 * MiB, WS_VH = 240 * MiB, WS_GH = 272 * MiB;
constexpr size_t WS_Y = 304 * MiB, WS_END = 432 * MiB;
constexpr int CW_BAR = 4096;
constexpr int RING_OFF = 0, RING_BYTES = 131072, LDSCTL_OFF = RING_BYTES, MISC_OFF = LDSCTL_OFF + 320, LDS_BYTES = 147456;

struct Frame {
    LAS unsigned char* lds; volatile LAS unsigned* MISC; gu32* ctl;
    int tid, lane, wave, vcu, G;
};
struct Args { const void* in[14]; float* out; unsigned char* ws; int ph_lo, ph_hi; };

__device__ __forceinline__ float wave_sum(float v) {
#pragma unroll
    for (int o = 1; o < 64; o <<= 1) v += __shfl_xor(v, o);
    return v;
}
__device__ __forceinline__ float bf2f(unsigned short h) { return __builtin_bit_cast(float, (unsigned)h << 16); }

__device__ __forceinline__ void transpose_item(const float* W, int K, int N, bf16* WT, int k0, int nsrc0, int ndst0, LAS float* scr, int lane) {
#pragma unroll 8
    for (int i = 0; i < 32; ++i) { const int kk = 2 * i + (lane >> 5); scr[kk * 33 + (lane & 31)] = W[(size_t)(k0 + kk) * N + nsrc0 + (lane & 31)]; }
    LDS_WAIT(); asm volatile("" ::: "memory");
    const int c = lane & 7;
#pragma unroll
    for (int j = 0; j < 4; ++j) { const int n = (lane >> 3) + 8 * j; const LAS float* s = scr + (8 * c) * 33 + n;
        v4u o; o.x = pk2(s[0 * 33], s[1 * 33]); o.y = pk2(s[2 * 33], s[3 * 33]); o.z = pk2(s[4 * 33], s[5 * 33]); o.w = pk2(s[6 * 33], s[7 * 33]);
        *(GAS v4u*)(WT + (size_t)(ndst0 + n) * K + k0 + 8 * c) = o; }
    LDS_WAIT(); asm volatile("" ::: "memory");
}
__device__ __forceinline__ int mix_src_col(int np) {
    const int t = np >> 8, r = np & 255, bj = r >> 7, j = r & 127;
    if (t < 2) return (4 * t + (j >> 5)) * 64 + 32 * bj + (j & 31);
    if (t == 2) return j < 64 ? 512 + (j >> 5) * 64 + 32 * bj + (j & 31) : 640 + 64 * bj + (j - 64);
    if (t <= 6) return (bj ? 1280 : 768) + (t - 3) * 128 + j;
    return 1792 + (t - 7) * 256 + r;
}
__device__ __forceinline__ int swiglu_src_col(int np) { const int t = np >> 8, r = np & 255; return (r >= 128 ? FF : 0) + t * 128 + (r & 127); }

__device__ __forceinline__ void sincos_d(double a, double& s, double& c) {
    const double q = __builtin_rint(a * 0.63661977236758134308);
    double r = __builtin_fma(-q, 1.57079632673412561417e+00, a); r = __builtin_fma(-q, 6.07710050650619224932e-11, r);
    const double z = r * r;
    double ps = 1.0 / 6227020800.0; ps = __builtin_fma(ps, z, -1.0 / 39916800.0); ps = __builtin_fma(ps, z, 1.0 / 362880.0); ps = __builtin_fma(ps, z, -1.0 / 5040.0);
    ps = __builtin_fma(ps, z, 1.0 / 120.0); ps = __builtin_fma(ps, z, -1.0 / 6.0); ps = __builtin_fma(ps * z, r, r);
    double pc = -1.0 / 87178291200.0; pc = __builtin_fma(pc, z, 1.0 / 479001600.0); pc = __builtin_fma(pc, z, -1.0 / 3628800.0); pc = __builtin_fma(pc, z, 1.0 / 40320.0);
    pc = __builtin_fma(pc, z, -1.0 / 720.0); pc = __builtin_fma(pc, z, 1.0 / 24.0); pc = __builtin_fma(pc, z, -0.5); pc = __builtin_fma(pc, z, 1.0);
    const int qi = (int)q & 3;
    s = (qi == 0) ? ps : (qi == 1) ? pc : (qi == 2) ? -ps : -pc;
    c = (qi == 0) ? pc : (qi == 1) ? -ps : (qi == 2) ? -pc : ps;
}

struct Ptrs {
    const float *x, *c, *w_cond, *b_cond, *norm_pre, *norm_post, *ffn_w_in, *ffn_w_out, *w_mix_in, *w_mix_out, *sinks, *lbl, *gnorm; const int* pos;
    float* out; unsigned char* ws;
};

__device__ __forceinline__ void p0a(Frame& F, const Ptrs& P) {
    float* MODP = (float*)(P.ws + WS_MODP);
    for (int it = F.vcu; it < 256; it += F.G) {
        const int cb = it & 31, ks = it >> 5;
        LAS float* cact = (LAS float*)(F.lds); LAS float* red = cact + 1024;
        for (int i = F.tid; i < 1024; i += NWAVES * 64) { const float cv = P.c[(i >> 7) * D + ks * 128 + (i & 127)]; cact[i] = cv / (1.0f + __expf(-cv)); }
        __syncthreads();
        if (F.tid < 504) {
            const int col4 = F.tid % 72, kg = F.tid / 72;
            f32x4 a[8];
#pragma unroll
            for (int b = 0; b < 8; ++b) a[b] = (f32x4){0.f, 0.f, 0.f, 0.f};
            for (int k = kg; k < 128; k += 7) { const f32x4 w = *(const f32x4*)(P.w_cond + (size_t)(ks * 128 + k) * NMOD + cb * 288 + col4 * 4);
#pragma unroll
                for (int b = 0; b < 8; ++b) a[b] += w * cact[b * 128 + k]; }
#pragma unroll
            for (int b = 0; b < 8; ++b) *(LAS f32x4*)(red + (kg * 8 + b) * 288 + col4 * 4) = a[b];
        }
        __syncthreads();
        for (int i = F.tid; i < 8 * 288; i += NWAVES * 64) { const int b = i / 288, cc = i % 288; float s = 0.f;
#pragma unroll
            for (int kg = 0; kg < 7; ++kg) s += red[(kg * 8 + b) * 288 + cc];
            MODP[(size_t)(ks * 8 + b) * NMOD + cb * 288 + cc] = s; }
        __syncthreads();
    }
    {
        LAS float* scr = (LAS float*)(F.lds + RING_OFF + F.wave * 16384);
        const int gw = F.vcu * NWAVES + F.wave, NGW = F.G * NWAVES;
        constexpr int I_IN = (D / 64) * (2 * FF / 32), I_OUT = (FF / 64) * (D / 32), I_MI = (D / 64) * (NPROJ / 32), I_MO = (D / 64) * (D / 32);
        constexpr int NITEMS = 2 * I_IN + 2 * I_OUT + I_MI + I_MO;
        for (int it = gw; it < NITEMS; it += NGW) {
            int r = it;
            if (r < 2 * I_IN) { const int l = r / I_IN; r -= l * I_IN; const int nblk = 2 * FF / 32, kb = r / nblk, nb = r % nblk;
                transpose_item(P.ffn_w_in + (size_t)l * D * 2 * FF, D, 2 * FF, (bf16*)(P.ws + (l ? WS_W1B : WS_W1A)), 64 * kb, swiglu_src_col(32 * nb), 32 * nb, scr, F.lane); continue; }
            r -= 2 * I_IN;
            if (r < 2 * I_OUT) { const int l = r / I_OUT; r -= l * I_OUT; const int nblk = D / 32, kb = r / nblk, nb = r % nblk;
                transpose_item(P.ffn_w_out + (size_t)l * FF * D, FF, D, (bf16*)(P.ws + (l ? WS_W2B : WS_W2A)), 64 * kb, 32 * nb, 32 * nb, scr, F.lane); continue; }
            r -= 2 * I_OUT;
            if (r < I_MI) { const int nblk = NPROJ / 32, kb = r / nblk, nb = r % nblk;
                transpose_item(P.w_mix_in, D, NPROJ, (bf16*)(P.ws + WS_WMI), 64 * kb, mix_src_col(32 * nb), 32 * nb, scr, F.lane); continue; }
            r -= I_MI;
            { const int nblk = D / 32, kb = r / nblk, nb = r % nblk; transpose_item(P.w_mix_out, D, D, (bf16*)(P.ws + WS_WMO), 64 * kb, 32 * nb, 32 * nb, scr, F.lane); }
        }
    }
    {
        float* cosT = (float*)(P.ws + WS_COS); float* sinT = (float*)(P.ws + WS_SIN);
        const int gt = F.vcu * NWAVES * 64 + F.tid, NGT = F.G * NWAVES * 64;
        for (int idx = gt; idx < M * 32; idx += NGT) {
            const int k = idx & 31; double inv = 1.0, rr = 0.7498942093324559;
#pragma unroll
            for (int bit = 0; bit < 5; ++bit) { if (k & (1 << bit)) inv *= rr; rr *= rr; }
            double s, c; sincos_d((double)P.pos[idx >> 5] * inv, s, c);
            cosT[idx] = (float)c; sinT[idx] = (float)s;
        }
    }
}

template <bool FROM_PART> __device__ __forceinline__ float modval(const float* modsrc, const float* b_cond, int b, int oc) {
    if (FROM_PART) { float s = b_cond[oc];
#pragma unroll
        for (int ks = 0; ks < 8; ++ks) s += modsrc[(size_t)(ks * 8 + b) * NMOD + oc];
        return s; }
    return modsrc[(size_t)b * NMOD + oc];
}
template <bool HAS_Y, bool HAS_H, bool FROM_PART>
__device__ __forceinline__ void row_pass(Frame& F, const Ptrs& P, const float* xi, const float* y, float* xo, bf16* ho, const float* modsrc,
                                         int gt_off, const float* gpost, float resw, int sh_off, int sc_off, const float* gpre) {
    LAS float* Gc = (LAS float*)(F.lds); LAS float* Ac = Gc + D; LAS float* Bc = Ac + D;
    for (int rb = F.vcu; rb < M / 128; rb += F.G) {
        const int b = rb / (SEQ / 128);
        for (int col = F.tid; col < D; col += NWAVES * 64) {
            if (HAS_Y) Gc[col] = resw * modval<FROM_PART>(modsrc, P.b_cond, b, gt_off + col) * gpost[col];
            if (HAS_H) { Ac[col] = gpre[col] * (1.0f + modval<FROM_PART>(modsrc, P.b_cond, b, sc_off + col)); Bc[col] = modval<FROM_PART>(modsrc, P.b_cond, b, sh_off + col); }
        }
        __syncthreads();
        for (int rr = 0; rr < 128 / NWAVES; ++rr) {
            const size_t row = (size_t)rb * 128 + F.wave * (128 / NWAVES) + rr;
            const f32x4* xr = (const f32x4*)(xi + row * D) + F.lane;
            f32x4 v[4];
#pragma unroll
            for (int j = 0; j < 4; ++j) v[j] = xr[64 * j];
            if (HAS_Y) {
                const f32x4* yr = (const f32x4*)(y + row * D) + F.lane; f32x4 yv[4]; float s = 0.f;
#pragma unroll
                for (int j = 0; j < 4; ++j) { yv[j] = yr[64 * j]; s += (yv[j].x * yv[j].x + yv[j].y * yv[j].y) + (yv[j].z * yv[j].z + yv[j].w * yv[j].w); }
                const float r = 1.0f / sqrtf(wave_sum(s) * (1.0f / D) + EPS);
#pragma unroll
                for (int j = 0; j < 4; ++j) { const f32x4 g = *(const LAS f32x4*)(Gc + 256 * j + 4 * F.lane); v[j] += g * yv[j] * r; }
                f32x4* xw = (f32x4*)(xo + row * D) + F.lane;
#pragma unroll
                for (int j = 0; j < 4; ++j) xw[64 * j] = v[j];
            }
            if (HAS_H) {
                float s2 = 0.f;
#pragma unroll
                for (int j = 0; j < 4; ++j) s2 += (v[j].x * v[j].x + v[j].y * v[j].y) + (v[j].z * v[j].z + v[j].w * v[j].w);
                const float r2 = 1.0f / sqrtf(wave_sum(s2) * (1.0f / D) + EPS);
                unsigned long long* o8 = (unsigned long long*)(ho + row * D) + F.lane;
#pragma unroll
                for (int j = 0; j < 4; ++j) { const f32x4 a = *(const LAS f32x4*)(Ac + 256 * j + 4 * F.lane), bb = *(const LAS f32x4*)(Bc + 256 * j + 4 * F.lane);
                    const f32x4 h = v[j] * r2 * a + bb;
                    o8[64 * j] = (unsigned long long)pk2(h.x, h.y) | ((unsigned long long)pk2(h.z, h.w) << 32); }
            }
        }
        __syncthreads();
    }
}

__device__ __forceinline__ void p0b(Frame& F, const Ptrs& P) {
    const float* MODP = (const float*)(P.ws + WS_MODP); float* MOD = (float*)(P.ws + WS_MOD);
    for (int idx = F.vcu * NWAVES * 64 + F.tid; idx < BATCH * NMOD; idx += F.G * NWAVES * 64) {
        const int b = idx / NMOD, col = idx % NMOD; float s = P.b_cond[col];
#pragma unroll
        for (int ks = 0; ks < 8; ++ks) s += MODP[(size_t)(ks * 8 + b) * NMOD + col];
        MOD[idx] = s;
    }
    row_pass<false, true, true>(F, P, P.x, nullptr, nullptr, (bf16*)(P.ws + WS_H), MODP, 0, nullptr, 0.f, 0 * D, 1 * D, P.norm_pre + 0 * D);
}

__device__ __forceinline__ void attn_slow(Frame& F, const Ptrs& P) {
    const bf16* Q = (const bf16*)(P.ws + WS_Q); const bf16* K = (const bf16*)(P.ws + WS_K); const bf16* V = (const bf16*)(P.ws + WS_V); bf16* CAT = (bf16*)(P.ws + WS_H);
    const int gw = F.vcu * NWAVES + F.wave, NGW = F.G * NWAVES;
    for (int it = gw; it < BATCH * 64 * 8; it += NGW) {
        const int head = it & 7, n = (it >> 3) & 63, b = it >> 9, hk = head >> 2;
        const size_t row = (size_t)b * SEQ + n * CHUNK + F.lane;
        float q[64], o[64];
#pragma unroll
        for (int g = 0; g < 8; ++g) { const v4u w = *(const v4u*)(Q + row * 512 + head * 64 + 8 * g);
            q[8 * g + 0] = bf2f(w.x & 0xffff); q[8 * g + 1] = bf2f(w.x >> 16); q[8 * g + 2] = bf2f(w.y & 0xffff); q[8 * g + 3] = bf2f(w.y >> 16);
            q[8 * g + 4] = bf2f(w.z & 0xffff); q[8 * g + 5] = bf2f(w.z >> 16); q[8 * g + 6] = bf2f(w.w & 0xffff); q[8 * g + 7] = bf2f(w.w >> 16); }
#pragma unroll
        for (int d = 0; d < 64; ++d) o[d] = 0.f;
        float mx = P.sinks[head] * 1.4426950408889634f, l = 1.0f;
        const int j0 = (n >= 2 ? n - 2 : 0) * CHUNK, j1 = (n + 1) * CHUNK;
        for (int j = j0; j < j1; ++j) {
            int off = 0; asm volatile("" : "+v"(off));
            const bf16* kp = K + ((size_t)b * SEQ + j) * 128 + hk * 64 + off; const bf16* vp = V + ((size_t)b * SEQ + j) * 128 + hk * 64 + off;
            float s = 0.f;
#pragma unroll
            for (int g = 0; g < 8; ++g) { const v4u w = *(const v4u*)(kp + 8 * g);
                s += q[8 * g + 0] * bf2f(w.x & 0xffff) + q[8 * g + 1] * bf2f(w.x >> 16) + q[8 * g + 2] * bf2f(w.y & 0xffff) + q[8 * g + 3] * bf2f(w.y >> 16)
                   + q[8 * g + 4] * bf2f(w.z & 0xffff) + q[8 * g + 5] * bf2f(w.z >> 16) + q[8 * g + 6] * bf2f(w.w & 0xffff) + q[8 * g + 7] * bf2f(w.w >> 16); }
            const float mn = fmaxf(mx, s), a = exp2f(mx - mn), p = exp2f(s - mn);
            l = l * a + p; mx = mn;
#pragma unroll
            for (int g = 0; g < 8; ++g) { const v4u w = *(const v4u*)(vp + 8 * g);
                o[8 * g + 0] = o[8 * g + 0] * a + p * bf2f(w.x & 0xffff); o[8 * g + 1] = o[8 * g + 1] * a + p * bf2f(w.x >> 16);
                o[8 * g + 2] = o[8 * g + 2] * a + p * bf2f(w.y & 0xffff); o[8 * g + 3] = o[8 * g + 3] * a + p * bf2f(w.y >> 16);
                o[8 * g + 4] = o[8 * g + 4] * a + p * bf2f(w.z & 0xffff); o[8 * g + 5] = o[8 * g + 5] * a + p * bf2f(w.z >> 16);
                o[8 * g + 6] = o[8 * g + 6] * a + p * bf2f(w.w & 0xffff); o[8 * g + 7] = o[8 * g + 7] * a + p * bf2f(w.w >> 16); }
        }
        const float inv = 1.0f / l;
#pragma unroll
        for (int g = 0; g < 8; ++g) { v4u w; w.x = pk2(o[8 * g] * inv, o[8 * g + 1] * inv); w.y = pk2(o[8 * g + 2] * inv, o[8 * g + 3] * inv); w.z = pk2(o[8 * g + 4] * inv, o[8 * g + 5] * inv); w.w = pk2(o[8 * g + 6] * inv, o[8 * g + 7] * inv);
            *(v4u*)(CAT + row * D + head * 64 + 8 * g) = w; }
    }
}
__device__ __forceinline__ void hgrn_slow(Frame& F, const Ptrs& P) {
    const bf16* QT = (const bf16*)(P.ws + WS_QT); const bf16* KH = (const bf16*)(P.ws + WS_KH); const bf16* VH = (const bf16*)(P.ws + WS_VH); const bf16* GH = (const bf16*)(P.ws + WS_GH);
    const float* EBL = (const float*)(P.ws + WS_EBL); bf16* CAT = (bf16*)(P.ws + WS_H);
    LAS bf16* qL = (LAS bf16*)(F.lds); LAS bf16* kL = qL + 32 * 128; LAS bf16* vL = kL + 32 * 128; LAS float* part = (LAS float*)(F.lds + 32768);
    for (int it = F.vcu; it < BATCH * 4; it += F.G) {
        const int b = it >> 2, hh = it & 3, e = F.tid & 127, dq = F.tid >> 7;
        float R[32];
#pragma unroll
        for (int i = 0; i < 32; ++i) R[i] = 0.f;
        for (int c = 0; c < 64; ++c) {
            for (int half = 0; half < 2; ++half) {
                const size_t row0 = (size_t)b * SEQ + c * CHUNK + half * 32;
                { const int r = F.tid >> 4, ch = F.tid & 15; const size_t g = (row0 + r) * 512 + hh * 128 + ch * 8;
                  *(LAS v4u*)(qL + r * 128 + ch * 8) = *(const v4u*)(QT + g); *(LAS v4u*)(kL + r * 128 + ch * 8) = *(const v4u*)(KH + g); *(LAS v4u*)(vL + r * 128 + ch * 8) = *(const v4u*)(VH + g); }
                __syncthreads();
                for (int t = 0; t < 32; ++t) {
                    const float ve = bf2f(vL[t * 128 + e]); float partial = 0.f;
#pragma unroll
                    for (int g = 0; g < 4; ++g) { const v4u kw = *(const LAS v4u*)(kL + t * 128 + dq * 32 + 8 * g), qw = *(const LAS v4u*)(qL + t * 128 + dq * 32 + 8 * g);
                        const unsigned kk[4] = {kw.x, kw.y, kw.z, kw.w}, qq[4] = {qw.x, qw.y, qw.z, qw.w};
#pragma unroll
                        for (int p2 = 0; p2 < 4; ++p2) {
                            R[8 * g + 2 * p2] += bf2f(kk[p2] & 0xffff) * ve; partial += bf2f(qq[p2] & 0xffff) * R[8 * g + 2 * p2];
                            R[8 * g + 2 * p2 + 1] += bf2f(kk[p2] >> 16) * ve; partial += bf2f(qq[p2] >> 16) * R[8 * g + 2 * p2 + 1]; } }
                    part[(dq * 32 + t) * 128 + e] = partial;
                }
                __syncthreads();
                { const int t = F.tid >> 4, e8 = (F.tid & 15) * 8; float o[8]; float ss = 0.f;
#pragma unroll
                  for (int k = 0; k < 8; ++k) { o[k] = (part[(0 * 32 + t) * 128 + e8 + k] + part[(1 * 32 + t) * 128 + e8 + k]) + (part[(2 * 32 + t) * 128 + e8 + k] + part[(3 * 32 + t) * 128 + e8 + k]); ss += o[k] * o[k]; }
                  ss += __shfl_xor(ss, 1); ss += __shfl_xor(ss, 2); ss += __shfl_xor(ss, 4); ss += __shfl_xor(ss, 8);
                  const float r = 1.0f / sqrtf(ss * (1.0f / 128.0f) + EPS);
                  const v4u gw = *(const v4u*)(GH + (row0 + t) * 512 + hh * 128 + e8); const unsigned gg[4] = {gw.x, gw.y, gw.z, gw.w};
                  v4u w; unsigned ww[4];
#pragma unroll
                  for (int p2 = 0; p2 < 4; ++p2) ww[p2] = pk2(o[2 * p2] * r * P.gnorm[e8 + 2 * p2] * bf2f(gg[p2] & 0xffff), o[2 * p2 + 1] * r * P.gnorm[e8 + 2 * p2 + 1] * bf2f(gg[p2] >> 16));
                  w.x = ww[0]; w.y = ww[1]; w.z = ww[2]; w.w = ww[3];
                  *(v4u*)(CAT + (row0 + t) * D + 512 + hh * 128 + e8) = w; }
                __syncthreads();
            }
#pragma unroll
            for (int i = 0; i < 32; ++i) R[i] *= EBL[(size_t)(b * 64 + c) * 512 + hh * 128 + dq * 32 + i];
        }
    }
}

__global__ void __launch_bounds__(NWAVES * 64, 2) mk_fwd(Args args) {
    extern __shared__ __attribute__((aligned(16))) unsigned char lds[];
    Frame F;
    F.lds = (LAS unsigned char*)lds; F.MISC = (volatile LAS unsigned*)(F.lds + MISC_OFF);
    F.tid = threadIdx.x; F.lane = F.tid & 63; F.wave = __builtin_amdgcn_readfirstlane(F.tid >> 6);
    F.G = gridDim.x; { const int bx = blockIdx.x; F.vcu = (F.G % 8 == 0) ? (bx % 8) * (F.G / 8) + bx / 8 : bx; }
    Ptrs P;
    P.x = (const float*)args.in[0]; P.c = (const float*)args.in[1]; P.pos = (const int*)args.in[2]; P.w_cond = (const float*)args.in[3]; P.b_cond = (const float*)args.in[4];
    P.norm_pre = (const float*)args.in[5]; P.norm_post = (const float*)args.in[6]; P.ffn_w_in = (const float*)args.in[7]; P.ffn_w_out = (const float*)args.in[8];
    P.w_mix_in = (const float*)args.in[9]; P.w_mix_out = (const float*)args.in[10]; P.sinks = (const float*)args.in[11]; P.lbl = (const float*)args.in[12]; P.gnorm = (const float*)args.in[13];
    P.out = args.out; P.ws = args.ws;
    F.ctl = (gu32*)(P.ws + WS_CTL);
    for (int u = F.tid; u < (LDS_BYTES - LDSCTL_OFF) / 4; u += NWAVES * 64) ((LAS unsigned*)(F.lds + LDSCTL_OFF))[u] = 0u;
    __syncthreads();
    const int lo = args.ph_lo, hi = args.ph_hi;
    const bool use_bar = (hi - lo) > 1;
    XcdBarrier bar; bar.bar = (unsigned*)(F.ctl + CW_BAR); bar.x = 0; bar.st = nullptr;
    if (use_bar) bar = xcd_barrier_post((unsigned*)(F.ctl + CW_BAR), F.MISC + 8);
#define IN(k) (lo <= (k) && (k) < hi)
#define SEAM(k) do { if (IN(k) && IN((k) + 1)) xcd_barrier(bar); } while (0)
    const float* MOD = (const float*)(P.ws + WS_MOD);
    bf16* HB = (bf16*)(P.ws + WS_H); bf16* UB = (bf16*)(P.ws + WS_U); float* YB = (float*)(P.ws + WS_Y);

    if (IN(0)) { p0a(F, P); } SEAM(0);
    if (IN(1)) { p0b(F, P); } SEAM(1);
    if (IN(2)) {
        pg8::Gemm g{HB, (const bf16*)(P.ws + WS_W1A), M, 2 * FF, D}; pg8::StaticOrder S; S.init(M, 2 * FF, F.G, (int)blockIdx.x);
        pg8::EpiSwiGLU E{UB, FF};
        pg8::gemm_phase<pg8::EpiSwiGLU, pg8::StaticOrder, true, true>(F.lds + RING_OFF, g, S, E);
    } SEAM(2);
    if (IN(3)) {
        pg8::Gemm g{UB, (const bf16*)(P.ws + WS_W2A), M, D, FF}; pg8::StaticOrder S; S.init(M, D, F.G, (int)blockIdx.x);
        pg8::EpiF32 E{YB, D};
        pg8::gemm_phase<pg8::EpiF32, pg8::StaticOrder, true, true>(F.lds + RING_OFF, g, S, E);
    } SEAM(3);
    if (IN(4)) {
        row_pass<true, true, false>(F, P, P.x, YB, P.out, HB, MOD, 2 * D, P.norm_post + 0 * D, 0.5f, 3 * D, 4 * D, P.norm_pre + 1 * D);
    } SEAM(4);
    if (IN(5)) {
        pg8::Gemm g{HB, (const bf16*)(P.ws + WS_WMI), M, NPROJ, D}; pg8::StaticOrder S; S.init(M, NPROJ, F.G, (int)blockIdx.x);
        pg8::EpiMix E{(bf16*)(P.ws + WS_Q), (bf16*)(P.ws + WS_K), (bf16*)(P.ws + WS_V), (bf16*)(P.ws + WS_QT), (bf16*)(P.ws + WS_KH), (bf16*)(P.ws + WS_VH), (bf16*)(P.ws + WS_GH),
                      (float*)(P.ws + WS_EBL), (const float*)(P.ws + WS_COS), (const float*)(P.ws + WS_SIN), P.lbl};
        pg8::gemm_phase<pg8::EpiMix, pg8::StaticOrder, true, true>(F.lds + RING_OFF, g, S, E);
    } SEAM(5);
    if (IN(6)) {
        hgrn_slow(F, P);
        attn_slow(F, P);
    } SEAM(6);
    if (IN(7)) {
        pg8::Gemm g{HB, (const bf16*)(P.ws + WS_WMO), M, D, D}; pg8::StaticOrder S; S.init(M, D, F.G, (int)blockIdx.x);
        pg8::EpiF32 E{YB, D};
        pg8::gemm_phase<pg8::EpiF32, pg8::StaticOrder, true, true>(F.lds + RING_OFF, g, S, E);
    } SEAM(7);
    if (IN(8)) {
        row_pass<true, true, false>(F, P, P.out, YB, P.out, HB, MOD, 5 * D, P.norm_post + 1 * D, 1.0f, 6 * D, 7 * D, P.norm_pre + 2 * D);
    } SEAM(8);
    if (IN(9)) {
        pg8::Gemm g{HB, (const bf16*)(P.ws + WS_W1B), M, 2 * FF, D}; pg8::StaticOrder S; S.init(M, 2 * FF, F.G, (int)blockIdx.x);
        pg8::EpiSwiGLU E{UB, FF};
        pg8::gemm_phase<pg8::EpiSwiGLU, pg8::StaticOrder, true, true>(F.lds + RING_OFF, g, S, E);
    } SEAM(9);
    if (IN(10)) {
        pg8::Gemm g{UB, (const bf16*)(P.ws + WS_W2B), M, D, FF}; pg8::StaticOrder S; S.init(M, D, F.G, (int)blockIdx.x);
        pg8::EpiF32 E{YB, D};
        pg8::gemm_phase<pg8::EpiF32, pg8::StaticOrder, true, true>(F.lds + RING_OFF, g, S, E);
    } SEAM(10);
    if (IN(11)) {
        row_pass<true, false, false>(F, P, P.out, YB, P.out, nullptr, MOD, 8 * D, P.norm_post + 2 * D, 0.5f, 0, 0, nullptr);
    }
#undef IN
#undef SEAM
}

constexpr int N_PHASES = 12;
#ifndef MK_SINGLE
#define MK_SINGLE 0
#endif
extern "C" void kernel_launch(void* const* d_in, const int* in_sizes, int n_in, void* d_out, int out_size, void* d_ws, size_t ws_size, hipStream_t stream) {
    static int grid = 0;
    if (grid == 0) {
        if (n_in != 14 || in_sizes[0] != M * D || out_size != M * D || ws_size < WS_END) { fprintf(stderr, "kernel_launch: unexpected shapes (n_in %d, in0 %d, out %d, ws %zu); nothing launched\n", n_in, n_in > 0 ? in_sizes[0] : -1, out_size, ws_size); grid = -1; return; }
        int dev = 0, cus = 0;
        if (hipGetDevice(&dev) != hipSuccess || hipDeviceGetAttribute(&cus, hipDeviceAttributeMultiprocessorCount, dev) != hipSuccess) { grid = -1; return; }
        if (hipFuncSetAttribute((const void*)mk_fwd, hipFuncAttributeMaxDynamicSharedMemorySize, LDS_BYTES) != hipSuccess) { fprintf(stderr, "kernel_launch: hipFuncSetAttribute failed\n"); grid = -1; return; }
        int per_cu = 0;
        if (hipOccupancyMaxActiveBlocksPerMultiprocessor(&per_cu, (const void*)mk_fwd, NWAVES * 64, LDS_BYTES) != hipSuccess || per_cu < 1) fprintf(stderr, "kernel_launch: occupancy query reports %d blocks per CU\n", per_cu);
        (void)hipGetLastError();
        grid = cus;
    }
    if (grid < 0) return;
    if (hipMemsetAsync((char*)d_ws + WS_CTL, 0, CTL_ZERO_BYTES, stream) != hipSuccess) return;
    Args a{};
    for (int i = 0; i < 14; ++i) a.in[i] = d_in[i];
    a.out = (float*)d_out; a.ws = (unsigned char*)d_ws;
#if MK_SINGLE
    a.ph_lo = 0; a.ph_hi = N_PHASES;
    hipLaunchKernelGGL(mk_fwd, dim3(grid), dim3(NWAVES * 64), LDS_BYTES, stream, a);
#else
    for (int p = 0; p < N_PHASES; ++p) { a.ph_lo = p; a.ph_hi = p + 1; hipLaunchKernelGGL(mk_fwd, dim3(grid), dim3(NWAVES * 64), LDS_BYTES, stream, a); }
#endif
}
```

```cpp
#include <hip/hip_runtime.h>
#include <cstdio>
#include <cstdint>
namespace pg8 {
#define PG8_LAS __attribute__((address_space(3)))
typedef unsigned short bf16_t;
typedef short bf16x8 __attribute__((ext_vector_type(8)));
typedef float f32x4 __attribute__((ext_vector_type(4)));
typedef unsigned u32x4 __attribute__((ext_vector_type(4)));
constexpr int BM = 256, BK = 64, HALF = 128, HTB = HALF * BK * 2  , STAGE_BYTES = 8 * HTB, NXCD = 8, WGM = 8;

__host__ __device__ __forceinline__ int lds_byte(int r, int c) { const int st = (r >> 4) * 2 + (c >> 5), rr = r & 15, cc = c & 31, ob = rr * 64 + cc * 2; return st * 1024 + (ob ^ (((ob >> 9) & 1) << 5)); }
__host__ __device__ __forceinline__ void stage_rc(int b, int& R, int& C) { const int st = b / 1024, sb = b % 1024, swz = sb ^ (((sb >> 9) & 1) << 5); R = (st >> 1) * 16 + swz / 64; C = (st & 1) * 32 + (swz % 64) / 2; }
__host__ __device__ __forceinline__ int perm32(int rho) { const int n = rho >> 4, i = rho & 15; return 8 * (i >> 2) + 4 * n + (i & 3); }

struct Unit { int pm, pn; };
struct Gemm { const bf16_t* A; const bf16_t* Bt; int M, N, K; };

struct StaticOrder {
    int nM, nN, nwg, G, c;
    __host__ __device__ void init(int M, int N, int G_, int c_) { nM = M / BM; nN = N / BM; nwg = nM * nN; G = G_; c = c_; }
    __host__ __device__ bool next(int i, Unit& u) const {
        const long L = (long)i * G + c; if (L >= nwg) return false;
        int wgid = (int)L; { const int q = nwg / NXCD, r = nwg % NXCD, xcd = wgid % NXCD, off = wgid / NXCD; wgid = (xcd < r ? xcd * (q + 1) : r * (q + 1) + (xcd - r) * q) + off; }
        const int nig = WGM * nN, gid = wgid / nig, fm = gid * WGM, gsz = (nM - fm) < WGM ? (nM - fm) : WGM;
        u.pm = fm + ((wgid % nig) % gsz); u.pn = (wgid % nig) / gsz; return true;
    }
    __device__ __forceinline__ void a_ready(const Unit&) const {}
    __device__ __forceinline__ void done(const Unit&) const {}
};

__device__ __forceinline__ unsigned cvt_pk_bf16(float lo, float hi) { unsigned r; asm volatile("v_cvt_pk_bf16_f32 %0, %1, %2" : "=v"(r) : "v"(lo), "v"(hi)); return r; }
typedef float f32x2 __attribute__((ext_vector_type(2)));
constexpr float LOG2E = 1.4426950408889634f;
__device__ __forceinline__ float fast_sigmoid(float x) { return __builtin_amdgcn_rcpf(1.0f + __builtin_amdgcn_exp2f(-LOG2E * x)); }
__device__ __forceinline__ float fast_silu(float x) { return x * fast_sigmoid(x); }
__device__ __forceinline__ u32x4 pack8(const f32x4 a, const f32x4 b) { u32x4 w; w.x = cvt_pk_bf16(a[0], a[1]); w.y = cvt_pk_bf16(a[2], a[3]); w.z = cvt_pk_bf16(b[0], b[1]); w.w = cvt_pk_bf16(b[2], b[3]); return w; }

struct EpiF32 {
    static constexpr bool PERM = false, AFTER_DRAIN = false;
    float* C; int ldc;
    __device__ __forceinline__ void operator()(const f32x4 (&acc)[2][2][4][2], const Unit& u, int wr, int wc, int fr, int fq) const {
        const int row0 = u.pm * BM + wr * 64 + fr, col0 = u.pn * BM + wc * 32 + 4 * fq;
#pragma unroll
        for (int ai = 0; ai < 2; ++ai)
#pragma unroll
            for (int m = 0; m < 4; ++m) { float* rowp = C + (size_t)(row0 + ai * HALF + m * 16) * ldc + col0;
#pragma unroll
                for (int bj = 0; bj < 2; ++bj)
#pragma unroll
                    for (int n = 0; n < 2; ++n) *(f32x4*)(rowp + bj * HALF + n * 16) = acc[ai][bj][m][n]; }
    }
};

struct EpiSwiGLU {
    static constexpr bool PERM = true, AFTER_DRAIN = false;
    bf16_t* O; int ldc;
    __device__ __forceinline__ void operator()(const f32x4 (&acc)[2][2][4][2], const Unit& u, int wr, int wc, int fr, int fq) const {
        const int row0 = u.pm * BM + wr * 64 + fr, col0 = u.pn * HALF + wc * 32 + 8 * fq;
#pragma unroll
        for (int ai = 0; ai < 2; ++ai)
#pragma unroll
            for (int m = 0; m < 4; ++m) {
                bf16_t* p = O + (size_t)(row0 + ai * HALF + m * 16) * ldc + col0;
                f32x4 r0, r1;
#pragma unroll
                for (int i = 0; i < 4; ++i) { r0[i] = fast_silu(acc[ai][0][m][0][i]) * acc[ai][1][m][0][i]; r1[i] = fast_silu(acc[ai][0][m][1][i]) * acc[ai][1][m][1][i]; }
                *(u32x4*)p = pack8(r0, r1);
            }
    }
};

template <int CTRL> __device__ __forceinline__ float dpp_mov0(float x) { return __builtin_bit_cast(float, __builtin_amdgcn_update_dpp(0, __builtin_bit_cast(int, x), CTRL, 0xf, 0xf, false)); }
__device__ __forceinline__ float row_incl_scan(float x) { x += dpp_mov0<0x111>(x); x += dpp_mov0<0x112>(x); x += dpp_mov0<0x114>(x); x += dpp_mov0<0x118>(x); return x; }

struct EpiMix {
    static constexpr bool PERM = true, AFTER_DRAIN = false;
    bf16_t *Q, *Kb, *Vb, *QT, *KH, *VH, *GH; float* EBL; const float* cosT; const float* sinT; const float* lbl;
    __device__ __forceinline__ void operator()(const f32x4 (&acc)[2][2][4][2], const Unit& u, int wr, int wc, int fr, int fq) const {
        const int pn = u.pn, row0 = u.pm * BM + wr * 64 + fr;
        if (pn <= 2) {
            if (pn < 2 || wc < 2) {
                const bool isq = pn < 2;
                bf16_t* base = isq ? Q : Kb; const int ld = isq ? 512 : 128; const int hcol = (isq ? (4 * pn + wc) : wc) * 64 + 8 * fq;
                const float sc = isq ? (0.125f * LOG2E) : 1.0f;
#pragma unroll
                for (int ai = 0; ai < 2; ++ai)
#pragma unroll
                    for (int m = 0; m < 4; ++m) {
                        const int row = row0 + ai * HALF + m * 16;
                        const f32x4 c0 = *(const f32x4*)(cosT + (size_t)row * 32 + 8 * fq), c1 = *(const f32x4*)(cosT + (size_t)row * 32 + 8 * fq + 4);
                        const f32x4 s0 = *(const f32x4*)(sinT + (size_t)row * 32 + 8 * fq), s1 = *(const f32x4*)(sinT + (size_t)row * 32 + 8 * fq + 4);
                        const f32x4 a0 = acc[ai][0][m][0], a1 = acc[ai][0][m][1], b0 = acc[ai][1][m][0], b1 = acc[ai][1][m][1];
                        const f32x4 o10 = (a0 * c0 - b0 * s0) * sc, o11 = (a1 * c1 - b1 * s1) * sc, o20 = (b0 * c0 + a0 * s0) * sc, o21 = (b1 * c1 + a1 * s1) * sc;
                        bf16_t* p = base + (size_t)row * ld + hcol;
                        *(u32x4*)p = pack8(o10, o11); *(u32x4*)(p + 32) = pack8(o20, o21);
                        asm volatile("" ::: "memory");
                    }
            } else {
#pragma unroll
                for (int ai = 0; ai < 2; ++ai)
#pragma unroll
                    for (int m = 0; m < 4; ++m) {
                        const int row = row0 + ai * HALF + m * 16;
#pragma unroll
                        for (int bj = 0; bj < 2; ++bj) *(u32x4*)(Vb + (size_t)row * 128 + 64 * bj + 32 * (wc - 2) + 8 * fq) = pack8(acc[ai][bj][m][0], acc[ai][bj][m][1]);
                    }
            }
        } else if (pn <= 6) {
            const int hh = pn - 3, dcol = hh * 128 + wc * 32 + 8 * fq;
            float lb[2][4], omlb[2][4];
#pragma unroll
            for (int n = 0; n < 2; ++n) { const f32x4 l0 = *(const f32x4*)(lbl + dcol + 4 * n), l1 = *(const f32x4*)(lbl + 512 + dcol + 4 * n);
#pragma unroll
                for (int i = 0; i < 4; ++i) { const float e = __expf(l1[i] - l0[i]); lb[n][i] = 1.0f / (1.0f + e); omlb[n][i] = e / (1.0f + e); } }
#pragma unroll
            for (int ai = 0; ai < 2; ++ai) {
                float b2[4][2][4];
#pragma unroll
                for (int m = 0; m < 4; ++m)
#pragma unroll
                    for (int n = 0; n < 2; ++n)
#pragma unroll
                        for (int i = 0; i < 4; ++i) { const float hf = __builtin_fminf(__builtin_fmaxf(acc[ai][1][m][n][i], -30.f), 30.f);
                            const float f = lb[n][i] + omlb[n][i] * fast_sigmoid(hf); b2[m][n][i] = __builtin_amdgcn_logf(f); }
#pragma unroll
                for (int n = 0; n < 2; ++n)
#pragma unroll
                    for (int i = 0; i < 4; ++i) { float carry = 0.f;
#pragma unroll
                        for (int m = 0; m < 4; ++m) { const float P = row_incl_scan(b2[m][n][i]); const float T = __shfl(P, (int)((threadIdx.x & 63u) | 15u)); b2[m][n][i] = P + carry; carry += T; } }
#pragma unroll
                for (int m = 0; m < 4; ++m) {
                    const int row = row0 + ai * HALF + m * 16;
                    f32x4 qo[2], ko[2], eb[2];
#pragma unroll
                    for (int n = 0; n < 2; ++n)
#pragma unroll
                        for (int i = 0; i < 4; ++i) { const float hq = acc[ai][0][m][n][i]; float hf = acc[ai][1][m][n][i]; asm volatile("" : "+v"(hf)); hf = __builtin_fminf(__builtin_fmaxf(hf, -30.f), 30.f);
                            const float e = __builtin_amdgcn_exp2f(-LOG2E * hf), r = __builtin_amdgcn_rcpf(1.0f + e), kk = omlb[n][i] * (e * r);
                            const float q = fast_silu(hq) * 0.08838834764831845f, bb = b2[m][n][i], eb_ = __builtin_amdgcn_exp2f(bb);
                            qo[n][i] = q * eb_; ko[n][i] = kk * __builtin_amdgcn_exp2f(-bb); eb[n][i] = eb_; }
                    *(u32x4*)(QT + (size_t)row * 512 + dcol) = pack8(qo[0], qo[1]);
                    *(u32x4*)(KH + (size_t)row * 512 + dcol) = pack8(ko[0], ko[1]);
                    if (m == 3 && fr == 15) { float* ep = EBL + (size_t)(u.pm * 4 + 2 * ai + wr) * 512 + dcol; *(f32x4*)ep = eb[0]; *(f32x4*)(ep + 4) = eb[1]; }
                    asm volatile("" ::: "memory");
                }
            }
        } else {
            const bool isg = pn >= 9; bf16_t* base = isg ? GH : VH; const int tcol = (pn - (isg ? 9 : 7)) * 256 + wc * 32 + 8 * fq;
#pragma unroll
            for (int ai = 0; ai < 2; ++ai)
#pragma unroll
                for (int m = 0; m < 4; ++m) {
                    const int row = row0 + ai * HALF + m * 16;
#pragma unroll
                    for (int bj = 0; bj < 2; ++bj) { f32x4 v0 = acc[ai][bj][m][0], v1 = acc[ai][bj][m][1];
                        if (isg) {
#pragma unroll
                            for (int i = 0; i < 4; ++i) { v0[i] = fast_silu(v0[i]); v1[i] = fast_silu(v1[i]); } }
                        *(u32x4*)(base + (size_t)row * 512 + tcol + bj * HALF) = pack8(v0, v1); }
                }
        }
    }
};
template <class Epi, class Sched, bool ALIGN_EPI = false, bool SP2 = false>
__device__ __forceinline__ void gemm_phase(PG8_LAS unsigned char* lds, const Gemm g, const Sched& S, const Epi& E) {
    const int tid = threadIdx.x, wid = __builtin_amdgcn_readfirstlane(tid >> 6), lane = tid & 63, wr = wid >> 2, wc = wid & 3, fr = lane & 15, fq = lane >> 4;
    const int K = g.K, nt = K / BK;
    unsigned voffA[2], voffB[2];
#pragma unroll
    for (int i = 0; i < 2; ++i) { int R, C; stage_rc(tid * 16 + i * 8192, R, C); const int Rb = Epi::PERM ? ((R & ~31) + perm32(R & 31)) : R;
        voffA[i] = (unsigned)(R * K + C) * 2u; voffB[i] = (unsigned)(Rb * K + C) * 2u; }
    const size_t kstep = (size_t)(BK * 2);
    const size_t hstep = (size_t)HALF * K * 2;
    const size_t tstep = 2 * hstep;
    const unsigned ldsw = (unsigned)wid * 1024u;
    const int aoff = lds_byte(wr * 64 + fr, fq * 8), boff = lds_byte(wc * 32 + fr, fq * 8);
#define PG8_SA(b, h) (((b) * 2 + (h)) * HTB)
#define PG8_SB(b, h) ((4 + (b) * 2 + (h)) * HTB)
#define PG8_STAGE(bufoff, gbase, voff) do { _Pragma("unroll") for (int _i = 0; _i < 2; ++_i) \
        __builtin_amdgcn_global_load_lds((const unsigned*)((const char*)(gbase) + (voff)[_i]), (PG8_LAS unsigned*)(lds + (bufoff) + ldsw + _i * 8192), 16, 0, 0); } while (0)
#define PG8_LDA(dst, b, h) do { _Pragma("unroll") for (int m = 0; m < 4; ++m) _Pragma("unroll") for (int k = 0; k < 2; ++k) dst[m][k] = *(const PG8_LAS bf16x8*)(lds + PG8_SA(b, h) + aoff + m * 2048 + k * 1024); } while (0)
#define PG8_LDB(dst, b, h) do { _Pragma("unroll") for (int n = 0; n < 2; ++n) _Pragma("unroll") for (int k = 0; k < 2; ++k) dst[n][k] = *(const PG8_LAS bf16x8*)(lds + PG8_SB(b, h) + boff + n * 2048 + k * 1024); } while (0)
#define PG8_MMA(ai, bj, At, Bt) do { __builtin_amdgcn_s_setprio(1); _Pragma("unroll") for (int m = 0; m < 4; ++m) _Pragma("unroll") for (int n = 0; n < 2; ++n) _Pragma("unroll") for (int k = 0; k < 2; ++k) \
        acc[ai][bj][m][n] = __builtin_amdgcn_mfma_f32_16x16x32_bf16(Bt[n][k], At[m][k], acc[ai][bj][m][n], 0, 0, 0); __builtin_amdgcn_s_setprio(0); } while (0)
#define PG8_WAIT_V(n) asm volatile("s_waitcnt vmcnt(" #n ")" ::: "memory")
#define PG8_WAIT_L(n) asm volatile("s_waitcnt lgkmcnt(" #n ")" ::: "memory")
#define PG8_BAR __builtin_amdgcn_s_barrier()
#define PG8_SCHED __builtin_amdgcn_sched_barrier(0)
    Unit cur, nxt; int ui = 0;
    if (!S.next(0, cur)) return;
    f32x4 acc[2][2][4][2];
#pragma unroll
    for (int a = 0; a < 2; ++a)
#pragma unroll
        for (int b = 0; b < 2; ++b)
#pragma unroll
            for (int m = 0; m < 4; ++m)
#pragma unroll
                for (int n = 0; n < 2; ++n) acc[a][b][m][n] = (f32x4){0.f, 0.f, 0.f, 0.f};
    bf16x8 At[4][2], B0[2][2], B1[2][2];
    const char* cA = (const char*)g.A + (size_t)cur.pm * tstep; const char* cB = (const char*)g.Bt + (size_t)cur.pn * tstep;
    S.a_ready(cur);
    if constexpr (SP2) {
        PG8_STAGE(PG8_SB(0, 0), cB, voffB); PG8_STAGE(PG8_SB(0, 1), cB + hstep, voffB); PG8_STAGE(PG8_SA(0, 0), cA, voffA); PG8_STAGE(PG8_SA(0, 1), cA + hstep, voffA);
        if (wr == 1) PG8_BAR;
        PG8_WAIT_V(2); PG8_BAR;
        PG8_STAGE(PG8_SB(1, 0), cB + kstep, voffB); PG8_STAGE(PG8_SA(1, 0), cA + kstep, voffA); PG8_STAGE(PG8_SB(1, 1), cB + hstep + kstep, voffB);
        PG8_WAIT_V(6); PG8_BAR;
    } else {
        PG8_STAGE(PG8_SB(0, 0), cB, voffB); PG8_STAGE(PG8_SA(0, 0), cA, voffA); PG8_STAGE(PG8_SB(0, 1), cB + hstep, voffB); PG8_STAGE(PG8_SA(0, 1), cA + hstep, voffA);
        if (wr == 1) PG8_BAR;
        PG8_WAIT_V(4); PG8_BAR;
        PG8_STAGE(PG8_SB(1, 0), cB + kstep, voffB); PG8_STAGE(PG8_SA(1, 0), cA + kstep, voffA); PG8_STAGE(PG8_SB(1, 1), cB + hstep + kstep, voffB);
        PG8_WAIT_V(6); PG8_BAR;
    }
    for (;;) {
        const bool has_next = S.next(ui + 1, nxt);
        const char* nA = has_next ? (const char*)g.A + (size_t)nxt.pm * tstep : cA; const char* nB = has_next ? (const char*)g.Bt + (size_t)nxt.pn * tstep : cB;
        for (int t = 0; t < nt; t += 2) {
            const bool last = (t == nt - 2);
            const char* a1 = cA + (size_t)(t + 1) * kstep;
            const char* a2 = last ? nA : cA + (size_t)(t + 2) * kstep; const char* b2 = last ? nB : cB + (size_t)(t + 2) * kstep;
            const char* a3 = a2 + kstep; const char* b3 = b2 + kstep;
            if (last && has_next) S.a_ready(nxt);
            if constexpr (SP2) {
            PG8_LDB(B0, 0, 0); PG8_LDB(B1, 0, 1); PG8_SCHED; PG8_LDA(At, 0, 0); PG8_STAGE(PG8_SA(1, 1), a1 + hstep, voffA);
            PG8_WAIT_V(8); PG8_WAIT_L(0); PG8_BAR; PG8_MMA(0, 0, At, B0); PG8_MMA(0, 1, At, B1); PG8_BAR; PG8_SCHED;
            PG8_LDA(At, 0, 1); PG8_STAGE(PG8_SB(0, 0), b2, voffB); PG8_STAGE(PG8_SB(0, 1), b2 + hstep, voffB); PG8_STAGE(PG8_SA(0, 0), a2, voffA);
            PG8_WAIT_V(8); PG8_WAIT_L(0); PG8_BAR; PG8_MMA(1, 0, At, B0); PG8_MMA(1, 1, At, B1); PG8_BAR; PG8_SCHED;
            PG8_LDB(B0, 1, 0); PG8_LDB(B1, 1, 1); PG8_SCHED; PG8_LDA(At, 1, 0); PG8_STAGE(PG8_SA(0, 1), a2 + hstep, voffA);
            PG8_WAIT_V(8); PG8_WAIT_L(0); PG8_BAR; PG8_MMA(0, 0, At, B0); PG8_MMA(0, 1, At, B1); PG8_BAR; PG8_SCHED;
            PG8_LDA(At, 1, 1); PG8_STAGE(PG8_SB(1, 0), b3, voffB); PG8_STAGE(PG8_SB(1, 1), b3 + hstep, voffB); PG8_STAGE(PG8_SA(1, 0), a3, voffA);
            PG8_WAIT_V(8); PG8_WAIT_L(0); PG8_BAR; PG8_MMA(1, 0, At, B0); PG8_MMA(1, 1, At, B1); PG8_BAR; PG8_SCHED;
            } else {
            PG8_LDB(B0, 0, 0); PG8_SCHED; PG8_LDA(At, 0, 0); PG8_STAGE(PG8_SA(1, 1), a1 + hstep, voffA);
            PG8_WAIT_L(8); PG8_BAR; PG8_WAIT_L(0); PG8_MMA(0, 0, At, B0); PG8_BAR; PG8_SCHED;
            PG8_LDB(B1, 0, 1); PG8_STAGE(PG8_SB(0, 0), b2, voffB);
            PG8_BAR; PG8_WAIT_L(0); PG8_MMA(0, 1, At, B1); PG8_BAR;
            PG8_LDA(At, 0, 1); PG8_STAGE(PG8_SA(0, 0), a2, voffA);
            PG8_BAR; PG8_WAIT_L(0); PG8_MMA(1, 0, At, B0); PG8_BAR; PG8_SCHED;
            PG8_STAGE(PG8_SB(0, 1), b2 + hstep, voffB);
            PG8_WAIT_V(6); PG8_BAR; PG8_MMA(1, 1, At, B1); PG8_BAR;
            PG8_LDB(B0, 1, 0); PG8_SCHED; PG8_LDA(At, 1, 0); PG8_STAGE(PG8_SA(0, 1), a2 + hstep, voffA);
            PG8_WAIT_L(8); PG8_BAR; PG8_WAIT_L(0); PG8_MMA(0, 0, At, B0); PG8_BAR; PG8_SCHED;
            PG8_LDB(B1, 1, 1); PG8_STAGE(PG8_SB(1, 0), b3, voffB);
            PG8_BAR; PG8_WAIT_L(0); PG8_MMA(0, 1, At, B1); PG8_BAR;
            PG8_LDA(At, 1, 1); PG8_STAGE(PG8_SA(1, 0), a3, voffA);
            PG8_BAR; PG8_WAIT_L(0); PG8_MMA(1, 0, At, B0); PG8_BAR; PG8_SCHED;
            PG8_STAGE(PG8_SB(1, 1), b3 + hstep, voffB);
            PG8_WAIT_V(6); PG8_BAR; PG8_MMA(1, 1, At, B1); PG8_BAR;
            }
        }
        if constexpr (ALIGN_EPI) { if (wr == 0) PG8_BAR; }
        if constexpr (!Epi::AFTER_DRAIN) { E(acc, cur, wr, wc, fr, fq); S.done(cur); }
        if (!has_next) break;
#pragma unroll
        for (int a = 0; a < 2; ++a)
#pragma unroll
            for (int b = 0; b < 2; ++b)
#pragma unroll
                for (int m = 0; m < 4; ++m)
#pragma unroll
                    for (int n = 0; n < 2; ++n) acc[a][b][m][n] = (f32x4){0.f, 0.f, 0.f, 0.f};
        cur = nxt; cA = nA; cB = nB; ++ui;
        if constexpr (ALIGN_EPI) { if (wr == 1) PG8_BAR; }
    }
    PG8_WAIT_V(0);
    if constexpr (!ALIGN_EPI) { if (wr == 0) PG8_BAR; }
    PG8_BAR;
    if constexpr (Epi::AFTER_DRAIN) { E.fused(acc, cur, wr, wc, fr, fq, lds, wid, lane); S.done(cur); }
#undef PG8_SA
#undef PG8_SB
#undef PG8_STAGE
#undef PG8_LDA
#undef PG8_LDB
#undef PG8_MMA
#undef PG8_WAIT_V
#undef PG8_WAIT_L
#undef PG8_BAR
#undef PG8_SCHED
}
}
#define GAS __attribute__((address_space(1)))
#define LAS __attribute__((address_space(3)))
typedef unsigned short bf16;
typedef unsigned v4u __attribute__((ext_vector_type(4)));
typedef float f32x4 __attribute__((ext_vector_type(4)));
typedef short bf16x8 __attribute__((ext_vector_type(8)));
typedef GAS unsigned gu32;
typedef GAS unsigned long long gu64;
#define RLX_AGENT __ATOMIC_RELAXED, __HIP_MEMORY_SCOPE_AGENT
#define LDS_WAIT() asm volatile("s_waitcnt lgkmcnt(0)" ::: "memory")
#define VM_WAIT() asm volatile("s_waitcnt vmcnt(0)" ::: "memory")
__device__ __forceinline__ unsigned long long rt() { return __builtin_amdgcn_s_memrealtime(); }
__device__ __forceinline__ unsigned f2bf(float f) { unsigned u = __builtin_bit_cast(unsigned, f); return (u + 0x7fffu + ((u >> 16) & 1u)) >> 16; }
__device__ __forceinline__ unsigned pk2(float lo, float hi) { return f2bf(lo) | (f2bf(hi) << 16); }

#define XB_TMO      128
#define XB_XCNT(j)  (256  + 64 * (j))
#define XB_XSUB(j)  (1280 + 64 * (j))
#define XB_XGEN(j)  (2304 + 64 * (j))
#define XB_TOP      3328
#define XB_TOPGEN   3392
#define XCD_BAR_WORDS 3456
#define XB_SPIN_CAP (1u << 18)

__device__ __forceinline__ unsigned xb_ld(unsigned* p)              { return __hip_atomic_load(p, __ATOMIC_RELAXED, __HIP_MEMORY_SCOPE_AGENT); }
__device__ __forceinline__ unsigned xb_add(unsigned* p, unsigned v) { return __hip_atomic_fetch_add(p, v, __ATOMIC_RELAXED, __HIP_MEMORY_SCOPE_AGENT); }
__device__ __forceinline__ unsigned xb_xcc_id() { return (unsigned)__builtin_amdgcn_s_getreg((3 << 11) | 20) & 0xFu; }
#define XB_SPIN(cond, bar) do { unsigned _sp = 0; while (cond) { __builtin_amdgcn_s_sleep(1); \
    if ((++_sp & 255u) == 0u) { if (xb_ld(&(bar)[XB_TMO])) break; if (_sp > XB_SPIN_CAP) { atomicAdd(&(bar)[XB_TMO], 1u); break; } } } } while (0)

struct XcdBarrier {
    unsigned* bar; unsigned x;
    volatile LAS unsigned* st;
};

__device__ __forceinline__ XcdBarrier xcd_barrier_post(unsigned* bar, volatile LAS unsigned* st) {
    XcdBarrier b; b.bar = bar; b.x = xb_xcc_id(); b.st = st;
    if (threadIdx.x == 0) (void)xb_add(&bar[XB_XCNT(b.x)], 1u);
    return b;
}
__device__ __forceinline__ void xcd_barrier_complete(unsigned* bar, unsigned x, unsigned& nloc, unsigned& nx) {
    const unsigned G = gridDim.x * gridDim.y * gridDim.z;
    unsigned sum, cnt, mine, sp = 0u;
    for (;;) {
        sum = 0u; cnt = 0u; mine = 0u;
#pragma unroll
        for (unsigned j = 0; j < 16; ++j) { const unsigned c = xb_ld(&bar[XB_XCNT(j)]); sum += c; cnt += (c > 0u) ? 1u : 0u; mine = (j == x) ? c : mine; }
        if (sum == G) break;
        __builtin_amdgcn_s_sleep(1);
        if ((++sp & 255u) == 0u) { if (xb_ld(&bar[XB_TMO])) break; if (sp > XB_SPIN_CAP) { atomicAdd(&bar[XB_TMO], 1u); break; } }
    }
    nloc = mine > 0u ? mine : 1u; nx = cnt > 0u ? cnt : 1u;
}

__device__ __forceinline__ void xcd_barrier(const XcdBarrier& b) {
    asm volatile("s_waitcnt vmcnt(0)" ::: "memory");
    __syncthreads();
    if (threadIdx.x == 0) {
        unsigned* bar = b.bar;
        __builtin_amdgcn_s_waitcnt(0);
        unsigned nloc = b.st[0], nx = b.st[1];
        if (nloc == 0u) { xcd_barrier_complete(bar, b.x, nloc, nx); b.st[0] = nloc; b.st[1] = nx; }
        const unsigned old = xb_add(&bar[XB_XSUB(b.x)], 1u);
        const unsigned gen = old / nloc;
        if (old + 1u == (gen + 1u) * nloc) {
            __builtin_amdgcn_fence(__ATOMIC_RELEASE, "agent");
            asm volatile("s_waitcnt vmcnt(0)" ::: "memory");
            const unsigned og = xb_add(&bar[XB_TOP], 1u);
            const unsigned tg = og / nx;
            if (og + 1u == (tg + 1u) * nx) xb_add(&bar[XB_TOPGEN], 1u);
            else XB_SPIN(xb_ld(&bar[XB_TOPGEN]) == tg, bar);
            __builtin_amdgcn_fence(__ATOMIC_ACQUIRE, "agent");
            xb_add(&bar[XB_XGEN(b.x)], 1u);
            asm volatile("s_waitcnt vmcnt(0)" ::: "memory");
        } else {
            XB_SPIN(xb_ld(&bar[XB_XGEN(b.x)]) == gen, bar);
            __builtin_amdgcn_fence(__ATOMIC_ACQUIRE, "agent");
            asm volatile("s_waitcnt vmcnt(0)" ::: "memory");
        }
    }
    __syncthreads();
}

constexpr int NWAVES = 8;
constexpr int BATCH = 8, SEQ = 4096, D = 1024, M = BATCH * SEQ, FF = 2816, NPROJ = 2816, NMOD = 9 * D, CHUNK = 64;
constexpr float EPS = 1e-6f;
constexpr size_t MiB = 1u << 20;
constexpr size_t WS_CTL = 0, CTL_ZERO_BYTES = 1 * MiB;
constexpr size_t WS_W1A = 2 * MiB, WS_W1B = 13 * MiB, WS_W2A = 24 * MiB, WS_W2B = 30 * MiB, WS_WMI = 36 * MiB, WS_WMO = 42 * MiB;
constexpr size_t WS_MODP = 44 * MiB, WS_MOD = 47 * MiB, WS_COS = 48 * MiB, WS_SIN = 52 * MiB, WS_EBL = 56 * MiB;
constexpr size_t WS_H = 64 * MiB;
constexpr size_t WS_U = 128 * MiB;
constexpr size_t WS_Q = 128 * MiB, WS_K = 160 * MiB, WS_V = 168 * MiB, WS_QT = 176 * MiB, WS_KH = 208 * MiB, WS_VH = 240 * MiB, WS_GH = 272 * MiB;
constexpr size_t WS_Y = 304 * MiB, WS_END = 432 * MiB;
constexpr int CW_BAR = 4096;
constexpr int RING_OFF = 0, RING_BYTES = 131072, LDSCTL_OFF = RING_BYTES, MISC_OFF = LDSCTL_OFF + 320, LDS_BYTES = 147456;

struct Frame {
    LAS unsigned char* lds; volatile LAS unsigned* MISC; gu32* ctl;
    int tid, lane, wave, vcu, G;
};
struct Args { const void* in[14]; float* out; unsigned char* ws; int ph_lo, ph_hi; };

__device__ __forceinline__ float wave_sum(float v) {
#pragma unroll
    for (int o = 1; o < 64; o <<= 1) v += __shfl_xor(v, o);
    return v;
}
__device__ __forceinline__ float bf2f(unsigned short h) { return __builtin_bit_cast(float, (unsigned)h << 16); }

__device__ __forceinline__ void transpose_item(const float* W, int K, int N, bf16* WT, int k0, int nsrc0, int ndst0, LAS float* scr, int lane) {
#pragma unroll 8
    for (int i = 0; i < 32; ++i) { const int kk = 2 * i + (lane >> 5); scr[kk * 33 + (lane & 31)] = W[(size_t)(k0 + kk) * N + nsrc0 + (lane & 31)]; }
    LDS_WAIT(); asm volatile("" ::: "memory");
    const int c = lane & 7;
#pragma unroll
    for (int j = 0; j < 4; ++j) { const int n = (lane >> 3) + 8 * j; const LAS float* s = scr + (8 * c) * 33 + n;
        v4u o; o.x = pk2(s[0 * 33], s[1 * 33]); o.y = pk2(s[2 * 33], s[3 * 33]); o.z = pk2(s[4 * 33], s[5 * 33]); o.w = pk2(s[6 * 33], s[7 * 33]);
        *(GAS v4u*)(WT + (size_t)(ndst0 + n) * K + k0 + 8 * c) = o; }
    LDS_WAIT(); asm volatile("" ::: "memory");
}
__device__ __forceinline__ int mix_src_col(int np) {
    const int t = np >> 8, r = np & 255, bj = r >> 7, j = r & 127;
    if (t < 2) return (4 * t + (j >> 5)) * 64 + 32 * bj + (j & 31);
    if (t == 2) return j < 64 ? 512 + (j >> 5) * 64 + 32 * bj + (j & 31) : 640 + 64 * bj + (j - 64);
    if (t <= 6) return (bj ? 1280 : 768) + (t - 3) * 128 + j;
    return 1792 + (t - 7) * 256 + r;
}
__device__ __forceinline__ int swiglu_src_col(int np) { const int t = np >> 8, r = np & 255; return (r >= 128 ? FF : 0) + t * 128 + (r & 127); }

__device__ __forceinline__ void sincos_d(double a, double& s, double& c) {
    const double q = __builtin_rint(a * 0.63661977236758134308);
    double r = __builtin_fma(-q, 1.57079632673412561417e+00, a); r = __builtin_fma(-q, 6.07710050650619224932e-11, r);
    const double z = r * r;
    double ps = 1.0 / 6227020800.0; ps = __builtin_fma(ps, z, -1.0 / 39916800.0); ps = __builtin_fma(ps, z, 1.0 / 362880.0); ps = __builtin_fma(ps, z, -1.0 / 5040.0);
    ps = __builtin_fma(ps, z, 1.0 / 120.0); ps = __builtin_fma(ps, z, -1.0 / 6.0); ps = __builtin_fma(ps * z, r, r);
    double pc = -1.0 / 87178291200.0; pc = __builtin_fma(pc, z, 1.0 / 479001600.0); pc = __builtin_fma(pc, z, -1.0 / 3628800.0); pc = __builtin_fma(pc, z, 1.0 / 40320.0);
    pc = __builtin_fma(pc, z, -1.0 / 720.0); pc = __builtin_fma(pc, z, 1.0 / 24.0); pc = __builtin_fma(pc, z, -0.5); pc = __builtin_fma(pc, z, 1.0);
    const int qi = (int)q & 3;
    s = (qi == 0) ? ps : (qi == 1) ? pc : (qi == 2) ? -ps : -pc;
    c = (qi == 0) ? pc : (qi == 1) ? -ps : (qi == 2) ? -pc : ps;
}

struct Ptrs {
    const float *x, *c, *w_cond, *b_cond, *norm_pre, *norm_post, *ffn_w_in, *ffn_w_out, *w_mix_in, *w_mix_out, *sinks, *lbl, *gnorm; const int* pos;
    float* out; unsigned char* ws;
};

__device__ __forceinline__ void p0a(Frame& F, const Ptrs& P) {
    float* MODP = (float*)(P.ws + WS_MODP);
    for (int it = F.vcu; it < 256; it += F.G) {
        const int cb = it & 31, ks = it >> 5;
        LAS float* cact = (LAS float*)(F.lds); LAS float* red = cact + 1024;
        for (int i = F.tid; i < 1024; i += NWAVES * 64) { const float cv = P.c[(i >> 7) * D + ks * 128 + (i & 127)]; cact[i] = cv / (1.0f + __expf(-cv)); }
        __syncthreads();
        if (F.tid < 504) {
            const int col4 = F.tid % 72, kg = F.tid / 72;
            f32x4 a[8];
#pragma unroll
            for (int b = 0; b < 8; ++b) a[b] = (f32x4){0.f, 0.f, 0.f, 0.f};
            for (int k = kg; k < 128; k += 7) { const f32x4 w = *(const f32x4*)(P.w_cond + (size_t)(ks * 128 + k) * NMOD + cb * 288 + col4 * 4);
#pragma unroll
                for (int b = 0; b < 8; ++b) a[b] += w * cact[b * 128 + k]; }
#pragma unroll
            for (int b = 0; b < 8; ++b) *(LAS f32x4*)(red + (kg * 8 + b) * 288 + col4 * 4) = a[b];
        }
        __syncthreads();
        for (int i = F.tid; i < 8 * 288; i += NWAVES * 64) { const int b = i / 288, cc = i % 288; float s = 0.f;
#pragma unroll
            for (int kg = 0; kg < 7; ++kg) s += red[(kg * 8 + b) * 288 + cc];
            MODP[(size_t)(ks * 8 + b) * NMOD + cb * 288 + cc] = s; }
        __syncthreads();
    }
    {
        LAS float* scr = (LAS float*)(F.lds + RING_OFF + F.wave * 16384);
        const int gw = F.vcu * NWAVES + F.wave, NGW = F.G * NWAVES;
        constexpr int I_IN = (D / 64) * (2 * FF / 32), I_OUT = (FF / 64) * (D / 32), I_MI = (D / 64) * (NPROJ / 32), I_MO = (D / 64) * (D / 32);
        constexpr int NITEMS = 2 * I_IN + 2 * I_OUT + I_MI + I_MO;
        for (int it = gw; it < NITEMS; it += NGW) {
            int r = it;
            if (r < 2 * I_IN) { const int l = r / I_IN; r -= l * I_IN; const int nblk = 2 * FF / 32, kb = r / nblk, nb = r % nblk;
                transpose_item(P.ffn_w_in + (size_t)l * D * 2 * FF, D, 2 * FF, (bf16*)(P.ws + (l ? WS_W1B : WS_W1A)), 64 * kb, swiglu_src_col(32 * nb), 32 * nb, scr, F.lane); continue; }
            r -= 2 * I_IN;
            if (r < 2 * I_OUT) { const int l = r / I_OUT; r -= l * I_OUT; const int nblk = D / 32, kb = r / nblk, nb = r % nblk;
                transpose_item(P.ffn_w_out + (size_t)l * FF * D, FF, D, (bf16*)(P.ws + (l ? WS_W2B : WS_W2A)), 64 * kb, 32 * nb, 32 * nb, scr, F.lane); continue; }
            r -= 2 * I_OUT;
            if (r < I_MI) { const int nblk = NPROJ / 32, kb = r / nblk, nb = r % nblk;
                transpose_item(P.w_mix_in, D, NPROJ, (bf16*)(P.ws + WS_WMI), 64 * kb, mix_src_col(32 * nb), 32 * nb, scr, F.lane); continue; }
            r -= I_MI;
            { const int nblk = D / 32, kb = r / nblk, nb = r % nblk; transpose_item(P.w_mix_out, D, D, (bf16*)(P.ws + WS_WMO), 64 * kb, 32 * nb, 32 * nb, scr, F.lane); }
        }
    }
    {
        float* cosT = (float*)(P.ws + WS_COS); float* sinT = (float*)(P.ws + WS_SIN);
        const int gt = F.vcu * NWAVES * 64 + F.tid, NGT = F.G * NWAVES * 64;
        for (int idx = gt; idx < M * 32; idx += NGT) {
            const int k = idx & 31; double inv = 1.0, rr = 0.7498942093324559;
#pragma unroll
            for (int bit = 0; bit < 5; ++bit) { if (k & (1 << bit)) inv *= rr; rr *= rr; }
            double s, c; sincos_d((double)P.pos[idx >> 5] * inv, s, c);
            cosT[idx] = (float)c; sinT[idx] = (float)s;
        }
    }
}

template <bool FROM_PART> __device__ __forceinline__ float modval(const float* modsrc, const float* b_cond, int b, int oc) {
    if (FROM_PART) { float s = b_cond[oc];
#pragma unroll
        for (int ks = 0; ks < 8; ++ks) s += modsrc[(size_t)(ks * 8 + b) * NMOD + oc];
        return s; }
    return modsrc[(size_t)b * NMOD + oc];
}
template <bool HAS_Y, bool HAS_H, bool FROM_PART>
__device__ __forceinline__ void row_pass(Frame& F, const Ptrs& P, const float* xi, const float* y, float* xo, bf16* ho, const float* modsrc,
                                         int gt_off, const float* gpost, float resw, int sh_off, int sc_off, const float* gpre) {
    LAS float* Gc = (LAS float*)(F.lds); LAS float* Ac = Gc + D; LAS float* Bc = Ac + D;
    for (int rb = F.vcu; rb < M / 128; rb += F.G) {
        const int b = rb / (SEQ / 128);
        for (int col = F.tid; col < D; col += NWAVES * 64) {
            if (HAS_Y) Gc[col] = resw * modval<FROM_PART>(modsrc, P.b_cond, b, gt_off + col) * gpost[col];
            if (HAS_H) { Ac[col] = gpre[col] * (1.0f + modval<FROM_PART>(modsrc, P.b_cond, b, sc_off + col)); Bc[col] = modval<FROM_PART>(modsrc, P.b_cond, b, sh_off + col); }
        }
        __syncthreads();
        for (int rr = 0; rr < 128 / NWAVES; ++rr) {
            const size_t row = (size_t)rb * 128 + F.wave * (128 / NWAVES) + rr;
            const f32x4* xr = (const f32x4*)(xi + row * D) + F.lane;
            f32x4 v[4];
#pragma unroll
            for (int j = 0; j < 4; ++j) v[j] = xr[64 * j];
            if (HAS_Y) {
                const f32x4* yr = (const f32x4*)(y + row * D) + F.lane; f32x4 yv[4]; float s = 0.f;
#pragma unroll
                for (int j = 0; j < 4; ++j) { yv[j] = yr[64 * j]; s += (yv[j].x * yv[j].x + yv[j].y * yv[j].y) + (yv[j].z * yv[j].z + yv[j].w * yv[j].w); }
                const float r = 1.0f / sqrtf(wave_sum(s) * (1.0f / D) + EPS);
#pragma unroll
                for (int j = 0; j < 4; ++j) { const f32x4 g = *(const LAS f32x4*)(Gc + 256 * j + 4 * F.lane); v[j] += g * yv[j] * r; }
                f32x4* xw = (f32x4*)(xo + row * D) + F.lane;
#pragma unroll
                for (int j = 0; j < 4; ++j) xw[64 * j] = v[j];
            }
            if (HAS_H) {
                float s2 = 0.f;
#pragma unroll
                for (int j = 0; j < 4; ++j) s2 += (v[j].x * v[j].x + v[j].y * v[j].y) + (v[j].z * v[j].z + v[j].w * v[j].w);
                const float r2 = 1.0f / sqrtf(wave_sum(s2) * (1.0f / D) + EPS);
                unsigned long long* o8 = (unsigned long long*)(ho + row * D) + F.lane;
#pragma unroll
                for (int j = 0; j < 4; ++j) { const f32x4 a = *(const LAS f32x4*)(Ac + 256 * j + 4 * F.lane), bb = *(const LAS f32x4*)(Bc + 256 * j + 4 * F.lane);
                    const f32x4 h = v[j] * r2 * a + bb;
                    o8[64 * j] = (unsigned long long)pk2(h.x, h.y) | ((unsigned long long)pk2(h.z, h.w) << 32); }
            }
        }
        __syncthreads();
    }
}

__device__ __forceinline__ void p0b(Frame& F, const Ptrs& P) {
    const float* MODP = (const float*)(P.ws + WS_MODP); float* MOD = (float*)(P.ws + WS_MOD);
    for (int idx = F.vcu * NWAVES * 64 + F.tid; idx < BATCH * NMOD; idx += F.G * NWAVES * 64) {
        const int b = idx / NMOD, col = idx % NMOD; float s = P.b_cond[col];
#pragma unroll
        for (int ks = 0; ks < 8; ++ks) s += MODP[(size_t)(ks * 8 + b) * NMOD + col];
        MOD[idx] = s;
    }
    row_pass<false, true, true>(F, P, P.x, nullptr, nullptr, (bf16*)(P.ws + WS_H), MODP, 0, nullptr, 0.f, 0 * D, 1 * D, P.norm_pre + 0 * D);
}

__device__ __forceinline__ void attn_slow(Frame& F, const Ptrs& P) {
    const bf16* Q = (const bf16*)(P.ws + WS_Q); const bf16* K = (const bf16*)(P.ws + WS_K); const bf16* V = (const bf16*)(P.ws + WS_V); bf16* CAT = (bf16*)(P.ws + WS_H);
    const int gw = F.vcu * NWAVES + F.wave, NGW = F.G * NWAVES;
    for (int it = gw; it < BATCH * 64 * 8; it += NGW) {
        const int head = it & 7, n = (it >> 3) & 63, b = it >> 9, hk = head >> 2;
        const size_t row = (size_t)b * SEQ + n * CHUNK + F.lane;
        float q[64], o[64];
#pragma unroll
        for (int g = 0; g < 8; ++g) { const v4u w = *(const v4u*)(Q + row * 512 + head * 64 + 8 * g);
            q[8 * g + 0] = bf2f(w.x & 0xffff); q[8 * g + 1] = bf2f(w.x >> 16); q[8 * g + 2] = bf2f(w.y & 0xffff); q[8 * g + 3] = bf2f(w.y >> 16);
            q[8 * g + 4] = bf2f(w.z & 0xffff); q[8 * g + 5] = bf2f(w.z >> 16); q[8 * g + 6] = bf2f(w.w & 0xffff); q[8 * g + 7] = bf2f(w.w >> 16); }
#pragma unroll
        for (int d = 0; d < 64; ++d) o[d] = 0.f;
        float mx = P.sinks[head] * 1.4426950408889634f, l = 1.0f;
        const int j0 = (n >= 2 ? n - 2 : 0) * CHUNK, j1 = (n + 1) * CHUNK;
        for (int j = j0; j < j1; ++j) {
            int off = 0; asm volatile("" : "+v"(off));
            const bf16* kp = K + ((size_t)b * SEQ + j) * 128 + hk * 64 + off; const bf16* vp = V + ((size_t)b * SEQ + j) * 128 + hk * 64 + off;
            float s = 0.f;
#pragma unroll
            for (int g = 0; g < 8; ++g) { const v4u w = *(const v4u*)(kp + 8 * g);
                s += q[8 * g + 0] * bf2f(w.x & 0xffff) + q[8 * g + 1] * bf2f(w.x >> 16) + q[8 * g + 2] * bf2f(w.y & 0xffff) + q[8 * g + 3] * bf2f(w.y >> 16)
                   + q[8 * g + 4] * bf2f(w.z & 0xffff) + q[8 * g + 5] * bf2f(w.z >> 16) + q[8 * g + 6] * bf2f(w.w & 0xffff) + q[8 * g + 7] * bf2f(w.w >> 16); }
            const float mn = fmaxf(mx, s), a = exp2f(mx - mn), p = exp2f(s - mn);
            l = l * a + p; mx = mn;
#pragma unroll
            for (int g = 0; g < 8; ++g) { const v4u w = *(const v4u*)(vp + 8 * g);
                o[8 * g + 0] = o[8 * g + 0] * a + p * bf2f(w.x & 0xffff); o[8 * g + 1] = o[8 * g + 1] * a + p * bf2f(w.x >> 16);
                o[8 * g + 2] = o[8 * g + 2] * a + p * bf2f(w.y & 0xffff); o[8 * g + 3] = o[8 * g + 3] * a + p * bf2f(w.y >> 16);
                o[8 * g + 4] = o[8 * g + 4] * a + p * bf2f(w.z & 0xffff); o[8 * g + 5] = o[8 * g + 5] * a + p * bf2f(w.z >> 16);
                o[8 * g + 6] = o[8 * g + 6] * a + p * bf2f(w.w & 0xffff); o[8 * g + 7] = o[8 * g + 7] * a + p * bf2f(w.w >> 16); }
        }
        const float inv = 1.0f / l;
#pragma unroll
        for (int g = 0; g < 8; ++g) { v4u w; w.x = pk2(o[8 * g] * inv, o[8 * g + 1] * inv); w.y = pk2(o[8 * g + 2] * inv, o[8 * g + 3] * inv); w.z = pk2(o[8 * g + 4] * inv, o[8 * g + 5] * inv); w.w = pk2(o[8 * g + 6] * inv, o[8 * g + 7] * inv);
            *(v4u*)(CAT + row * D + head * 64 + 8 * g) = w; }
    }
}
__device__ __forceinline__ void hgrn_slow(Frame& F, const Ptrs& P) {
    const bf16* QT = (const bf16*)(P.ws + WS_QT); const bf16* KH = (const bf16*)(P.ws + WS_KH); const bf16* VH = (const bf16*)(P.ws + WS_VH); const bf16* GH = (const bf16*)(P.ws + WS_GH);
    const float* EBL = (const float*)(P.ws + WS_EBL); bf16* CAT = (bf16*)(P.ws + WS_H);
    LAS bf16* qL = (LAS bf16*)(F.lds); LAS bf16* kL = qL + 32 * 128; LAS bf16* vL = kL + 32 * 128; LAS float* part = (LAS float*)(F.lds + 32768);
    for (int it = F.vcu; it < BATCH * 4; it += F.G) {
        const int b = it >> 2, hh = it & 3, e = F.tid & 127, dq = F.tid >> 7;
        float R[32];
#pragma unroll
        for (int i = 0; i < 32; ++i) R[i] = 0.f;
        for (int c = 0; c < 64; ++c) {
            for (int half = 0; half < 2; ++half) {
                const size_t row0 = (size_t)b * SEQ + c * CHUNK + half * 32;
                { const int r = F.tid >> 4, ch = F.tid & 15; const size_t g = (row0 + r) * 512 + hh * 128 + ch * 8;
                  *(LAS v4u*)(qL + r * 128 + ch * 8) = *(const v4u*)(QT + g); *(LAS v4u*)(kL + r * 128 + ch * 8) = *(const v4u*)(KH + g); *(LAS v4u*)(vL + r * 128 + ch * 8) = *(const v4u*)(VH + g); }
                __syncthreads();
                for (int t = 0; t < 32; ++t) {
                    const float ve = bf2f(vL[t * 128 + e]); float partial = 0.f;
#pragma unroll
                    for (int g = 0; g < 4; ++g) { const v4u kw = *(const LAS v4u*)(kL + t * 128 + dq * 32 + 8 * g), qw = *(const LAS v4u*)(qL + t * 128 + dq * 32 + 8 * g);
                        const unsigned kk[4] = {kw.x, kw.y, kw.z, kw.w}, qq[4] = {qw.x, qw.y, qw.z, qw.w};
#pragma unroll
                        for (int p2 = 0; p2 < 4; ++p2) {
                            R[8 * g + 2 * p2] += bf2f(kk[p2] & 0xffff) * ve; partial += bf2f(qq[p2] & 0xffff) * R[8 * g + 2 * p2];
                            R[8 * g + 2 * p2 + 1] += bf2f(kk[p2] >> 16) * ve; partial += bf2f(qq[p2] >> 16) * R[8 * g + 2 * p2 + 1]; } }
                    part[(dq * 32 + t) * 128 + e] = partial;
                }
                __syncthreads();
                { const int t = F.tid >> 4, e8 = (F.tid & 15) * 8; float o[8]; float ss = 0.f;
#pragma unroll
                  for (int k = 0; k < 8; ++k) { o[k] = (part[(0 * 32 + t) * 128 + e8 + k] + part[(1 * 32 + t) * 128 + e8 + k]) + (part[(2 * 32 + t) * 128 + e8 + k] + part[(3 * 32 + t) * 128 + e8 + k]); ss += o[k] * o[k]; }
                  ss += __shfl_xor(ss, 1); ss += __shfl_xor(ss, 2); ss += __shfl_xor(ss, 4); ss += __shfl_xor(ss, 8);
                  const float r = 1.0f / sqrtf(ss * (1.0f / 128.0f) + EPS);
                  const v4u gw = *(const v4u*)(GH + (row0 + t) * 512 + hh * 128 + e8); const unsigned gg[4] = {gw.x, gw.y, gw.z, gw.w};
                  v4u w; unsigned ww[4];
#pragma unroll
                  for (int p2 = 0; p2 < 4; ++p2) ww[p2] = pk2(o[2 * p2] * r * P.gnorm[e8 + 2 * p2] * bf2f(gg[p2] & 0xffff), o[2 * p2 + 1] * r * P.gnorm[e8 + 2 * p2 + 1] * bf2f(gg[p2] >> 16));
                  w.x = ww[0]; w.y = ww[1]; w.z = ww[2]; w.w = ww[3];
                  *(v4u*)(CAT + (row0 + t) * D + 512 + hh * 128 + e8) = w; }
                __syncthreads();
            }
#pragma unroll
            for (int i = 0; i < 32; ++i) R[i] *= EBL[(size_t)(b * 64 + c) * 512 + hh * 128 + dq * 32 + i];
        }
    }
}

__global__ void __launch_bounds__(NWAVES * 64, 2) mk_fwd(Args args) {
    extern __shared__ __attribute__((aligned(16))) unsigned char lds[];
    Frame F;
    F.lds = (LAS unsigned char*)lds; F.MISC = (volatile LAS unsigned*)(F.lds + MISC_OFF);
    F.tid = threadIdx.x; F.lane = F.tid & 63; F.wave = __builtin_amdgcn_readfirstlane(F.tid >> 6);
    F.G = gridDim.x; { const int bx = blockIdx.x; F.vcu = (F.G % 8 == 0) ? (bx % 8) * (F.G / 8) + bx / 8 : bx; }
    Ptrs P;
    P.x = (const float*)args.in[0]; P.c = (const float*)args.in[1]; P.pos = (const int*)args.in[2]; P.w_cond = (const float*)args.in[3]; P.b_cond = (const float*)args.in[4];
    P.norm_pre = (const float*)args.in[5]; P.norm_post = (const float*)args.in[6]; P.ffn_w_in = (const float*)args.in[7]; P.ffn_w_out = (const float*)args.in[8];
    P.w_mix_in = (const float*)args.in[9]; P.w_mix_out = (const float*)args.in[10]; P.sinks = (const float*)args.in[11]; P.lbl = (const float*)args.in[12]; P.gnorm = (const float*)args.in[13];
    P.out = args.out; P.ws = args.ws;
    F.ctl = (gu32*)(P.ws + WS_CTL);
    for (int u = F.tid; u < (LDS_BYTES - LDSCTL_OFF) / 4; u += NWAVES * 64) ((LAS unsigned*)(F.lds + LDSCTL_OFF))[u] = 0u;
    __syncthreads();
    const int lo = args.ph_lo, hi = args.ph_hi;
    const bool use_bar = (hi - lo) > 1;
    XcdBarrier bar; bar.bar = (unsigned*)(F.ctl + CW_BAR); bar.x = 0; bar.st = nullptr;
    if (use_bar) bar = xcd_barrier_post((unsigned*)(F.ctl + CW_BAR), F.MISC + 8);
#define IN(k) (lo <= (k) && (k) < hi)
#define SEAM(k) do { if (IN(k) && IN((k) + 1)) xcd_barrier(bar); } while (0)
    const float* MOD = (const float*)(P.ws + WS_MOD);
    bf16* HB = (bf16*)(P.ws + WS_H); bf16* UB = (bf16*)(P.ws + WS_U); float* YB = (float*)(P.ws + WS_Y);

    if (IN(0)) { p0a(F, P); } SEAM(0);
    if (IN(1)) { p0b(F, P); } SEAM(1);
    if (IN(2)) {
        pg8::Gemm g{HB, (const bf16*)(P.ws + WS_W1A), M, 2 * FF, D}; pg8::StaticOrder S; S.init(M, 2 * FF, F.G, (int)blockIdx.x);
        pg8::EpiSwiGLU E{UB, FF};
        pg8::gemm_phase<pg8::EpiSwiGLU, pg8::StaticOrder, true, true>(F.lds + RING_OFF, g, S, E);
    } SEAM(2);
    if (IN(3)) {
        pg8::Gemm g{UB, (const bf16*)(P.ws + WS_W2A), M, D, FF}; pg8::StaticOrder S; S.init(M, D, F.G, (int)blockIdx.x);
        pg8::EpiF32 E{YB, D};
        pg8::gemm_phase<pg8::EpiF32, pg8::StaticOrder, true, true>(F.lds + RING_OFF, g, S, E);
    } SEAM(3);
    if (IN(4)) {
        row_pass<true, true, false>(F, P, P.x, YB, P.out, HB, MOD, 2 * D, P.norm_post + 0 * D, 0.5f, 3 * D, 4 * D, P.norm_pre + 1 * D);
    } SEAM(4);
    if (IN(5)) {
        pg8::Gemm g{HB, (const bf16*)(P.ws + WS_WMI), M, NPROJ, D}; pg8::StaticOrder S; S.init(M, NPROJ, F.G, (int)blockIdx.x);
        pg8::EpiMix E{(bf16*)(P.ws + WS_Q), (bf16*)(P.ws + WS_K), (bf16*)(P.ws + WS_V), (bf16*)(P.ws + WS_QT), (bf16*)(P.ws + WS_KH), (bf16*)(P.ws + WS_VH), (bf16*)(P.ws + WS_GH),
                      (float*)(P.ws + WS_EBL), (const float*)(P.ws + WS_COS), (const float*)(P.ws + WS_SIN), P.lbl};
        pg8::gemm_phase<pg8::EpiMix, pg8::StaticOrder, true, true>(F.lds + RING_OFF, g, S, E);
    } SEAM(5);
    if (IN(6)) {
        hgrn_slow(F, P);
        attn_slow(F, P);
    } SEAM(6);
    if (IN(7)) {
        pg8::Gemm g{HB, (const bf16*)(P.ws + WS_WMO), M, D, D}; pg8::StaticOrder S; S.init(M, D, F.G, (int)blockIdx.x);
        pg8::EpiF32 E{YB, D};
        pg8::gemm_phase<pg8::EpiF32, pg8::StaticOrder, true, true>(F.lds + RING_OFF, g, S, E);
    } SEAM(7);
    if (IN(8)) {
        row_pass<true, true, false>(F, P, P.out, YB, P.out, HB, MOD, 5 * D, P.norm_post + 1 * D, 1.0f, 6 * D, 7 * D, P.norm_pre + 2 * D);
    } SEAM(8);
    if (IN(9)) {
        pg8::Gemm g{HB, (const bf16*)(P.ws + WS_W1B), M, 2 * FF, D}; pg8::StaticOrder S; S.init(M, 2 * FF, F.G, (int)blockIdx.x);
        pg8::EpiSwiGLU E{UB, FF};
        pg8::gemm_phase<pg8::EpiSwiGLU, pg8::StaticOrder, true, true>(F.lds + RING_OFF, g, S, E);
    } SEAM(9);
    if (IN(10)) {
        pg8::Gemm g{UB, (const bf16*)(P.ws + WS_W2B), M, D, FF}; pg8::StaticOrder S; S.init(M, D, F.G, (int)blockIdx.x);
        pg8::EpiF32 E{YB, D};
        pg8::gemm_phase<pg8::EpiF32, pg8::StaticOrder, true, true>(F.lds + RING_OFF, g, S, E);
    } SEAM(10);
    if (IN(11)) {
        row_pass<true, false, false>(F, P, P.out, YB, P.out, nullptr, MOD, 8 * D, P.norm_post + 2 * D, 0.5f, 0, 0, nullptr);
    }
#undef IN
#undef SEAM
}

constexpr int N_PHASES = 12;
#ifndef MK_SINGLE
#define MK_SINGLE 1
#endif
extern "C" void kernel_launch(void* const* d_in, const int* in_sizes, int n_in, void* d_out, int out_size, void* d_ws, size_t ws_size, hipStream_t stream) {
    static int grid = 0;
    if (grid == 0) {
        if (n_in != 14 || in_sizes[0] != M * D || out_size != M * D || ws_size < WS_END) { fprintf(stderr, "kernel_launch: unexpected shapes (n_in %d, in0 %d, out %d, ws %zu); nothing launched\n", n_in, n_in > 0 ? in_sizes[0] : -1, out_size, ws_size); grid = -1; return; }
        int dev = 0, cus = 0;
        if (hipGetDevice(&dev) != hipSuccess || hipDeviceGetAttribute(&cus, hipDeviceAttributeMultiprocessorCount, dev) != hipSuccess) { grid = -1; return; }
        if (hipFuncSetAttribute((const void*)mk_fwd, hipFuncAttributeMaxDynamicSharedMemorySize, LDS_BYTES) != hipSuccess) { fprintf(stderr, "kernel_launch: hipFuncSetAttribute failed\n"); grid = -1; return; }
        int per_cu = 0;
        if (hipOccupancyMaxActiveBlocksPerMultiprocessor(&per_cu, (const void*)mk_fwd, NWAVES * 64, LDS_BYTES) != hipSuccess || per_cu < 1) fprintf(stderr, "kernel_launch: occupancy query reports %d blocks per CU\n", per_cu);
        (void)hipGetLastError();
        grid = cus;
    }
    if (grid < 0) return;
    if (hipMemsetAsync((char*)d_ws + WS_CTL, 0, CTL_ZERO_BYTES, stream) != hipSuccess) return;
    Args a{};
    for (int i = 0; i < 14; ++i) a.in[i] = d_in[i];
    a.out = (float*)d_out; a.ws = (unsigned char*)d_ws;
#if MK_SINGLE
    a.ph_lo = 0; a.ph_hi = N_PHASES;
    hipLaunchKernelGGL(mk_fwd, dim3(grid), dim3(NWAVES * 64), LDS_BYTES, stream, a);
#else
    for (int p = 0; p < N_PHASES; ++p) { a.ph_lo = p; a.ph_hi = p + 1; hipLaunchKernelGGL(mk_fwd, dim3(grid), dim3(NWAVES * 64), LDS_BYTES, stream, a); }
#endif
}
```

```cpp
#include <hip/hip_runtime.h>
#include <cstdio>
#include <cstdint>
namespace pg8 {
#define PG8_LAS __attribute__((address_space(3)))
typedef unsigned short bf16_t;
typedef short bf16x8 __attribute__((ext_vector_type(8)));
typedef float f32x4 __attribute__((ext_vector_type(4)));
typedef unsigned u32x4 __attribute__((ext_vector_type(4)));
constexpr int BM = 256, BK = 64, HALF = 128, HTB = HALF * BK * 2  , STAGE_BYTES = 8 * HTB, NXCD = 8, WGM = 8;

__host__ __device__ __forceinline__ int lds_byte(int r, int c) { const int st = (r >> 4) * 2 + (c >> 5), rr = r & 15, cc = c & 31, ob = rr * 64 + cc * 2; return st * 1024 + (ob ^ (((ob >> 9) & 1) << 5)); }
__host__ __device__ __forceinline__ void stage_rc(int b, int& R, int& C) { const int st = b / 1024, sb = b % 1024, swz = sb ^ (((sb >> 9) & 1) << 5); R = (st >> 1) * 16 + swz / 64; C = (st & 1) * 32 + (swz % 64) / 2; }
__host__ __device__ __forceinline__ int perm32(int rho) { const int n = rho >> 4, i = rho & 15; return 8 * (i >> 2) + 4 * n + (i & 3); }

struct Unit { int pm, pn; };
struct Gemm { const bf16_t* A; const bf16_t* Bt; int M, N, K; };

struct StaticOrder {
    int nM, nN, nwg, G, c;
    __host__ __device__ void init(int M, int N, int G_, int c_) { nM = M / BM; nN = N / BM; nwg = nM * nN; G = G_; c = c_; }
    __host__ __device__ bool next(int i, Unit& u) const {
        const long L = (long)i * G + c; if (L >= nwg) return false;
        int wgid = (int)L; { const int q = nwg / NXCD, r = nwg % NXCD, xcd = wgid % NXCD, off = wgid / NXCD; wgid = (xcd < r ? xcd * (q + 1) : r * (q + 1) + (xcd - r) * q) + off; }
        const int nig = WGM * nN, gid = wgid / nig, fm = gid * WGM, gsz = (nM - fm) < WGM ? (nM - fm) : WGM;
        u.pm = fm + ((wgid % nig) % gsz); u.pn = (wgid % nig) / gsz; return true;
    }
    __device__ __forceinline__ void a_ready(const Unit&) const {}
    __device__ __forceinline__ void done(const Unit&) const {}
};

__device__ __forceinline__ unsigned cvt_pk_bf16(float lo, float hi) { unsigned r; asm volatile("v_cvt_pk_bf16_f32 %0, %1, %2" : "=v"(r) : "v"(lo), "v"(hi)); return r; }
typedef float f32x2 __attribute__((ext_vector_type(2)));
constexpr float LOG2E = 1.4426950408889634f;
__device__ __forceinline__ float fast_sigmoid(float x) { return __builtin_amdgcn_rcpf(1.0f + __builtin_amdgcn_exp2f(-LOG2E * x)); }
__device__ __forceinline__ float fast_silu(float x) { return x * fast_sigmoid(x); }
__device__ __forceinline__ u32x4 pack8(const f32x4 a, const f32x4 b) { u32x4 w; w.x = cvt_pk_bf16(a[0], a[1]); w.y = cvt_pk_bf16(a[2], a[3]); w.z = cvt_pk_bf16(b[0], b[1]); w.w = cvt_pk_bf16(b[2], b[3]); return w; }

struct EpiF32 {
    static constexpr bool PERM = false, AFTER_DRAIN = false;
    float* C; int ldc;
    __device__ __forceinline__ void operator()(const f32x4 (&acc)[2][2][4][2], const Unit& u, int wr, int wc, int fr, int fq) const {
        const int row0 = u.pm * BM + wr * 64 + fr, col0 = u.pn * BM + wc * 32 + 4 * fq;
#pragma unroll
        for (int ai = 0; ai < 2; ++ai)
#pragma unroll
            for (int m = 0; m < 4; ++m) { float* rowp = C + (size_t)(row0 + ai * HALF + m * 16) * ldc + col0;
#pragma unroll
                for (int bj = 0; bj < 2; ++bj)
#pragma unroll
                    for (int n = 0; n < 2; ++n) *(f32x4*)(rowp + bj * HALF + n * 16) = acc[ai][bj][m][n]; }
    }
};

struct EpiSwiGLU {
    static constexpr bool PERM = true, AFTER_DRAIN = false;
    bf16_t* O; int ldc;
    __device__ __forceinline__ void operator()(const f32x4 (&acc)[2][2][4][2], const Unit& u, int wr, int wc, int fr, int fq) const {
        const int row0 = u.pm * BM + wr * 64 + fr, col0 = u.pn * HALF + wc * 32 + 8 * fq;
#pragma unroll
        for (int ai = 0; ai < 2; ++ai)
#pragma unroll
            for (int m = 0; m < 4; ++m) {
                bf16_t* p = O + (size_t)(row0 + ai * HALF + m * 16) * ldc + col0;
                f32x4 r0, r1;
#pragma unroll
                for (int i = 0; i < 4; ++i) { r0[i] = fast_silu(acc[ai][0][m][0][i]) * acc[ai][1][m][0][i]; r1[i] = fast_silu(acc[ai][0][m][1][i]) * acc[ai][1][m][1][i]; }
                *(u32x4*)p = pack8(r0, r1);
            }
    }
};

template <int CTRL> __device__ __forceinline__ float dpp_mov0(float x) { return __builtin_bit_cast(float, __builtin_amdgcn_update_dpp(0, __builtin_bit_cast(int, x), CTRL, 0xf, 0xf, false)); }
__device__ __forceinline__ float row_incl_scan(float x) { x += dpp_mov0<0x111>(x); x += dpp_mov0<0x112>(x); x += dpp_mov0<0x114>(x); x += dpp_mov0<0x118>(x); return x; }

struct EpiMix {
    static constexpr bool PERM = true, AFTER_DRAIN = false;
    bf16_t *Q, *Kb, *Vb, *QT, *KH, *VH, *GH; float* EBL; const float* cosT; const float* sinT; const float* lbl;
    __device__ __forceinline__ void operator()(const f32x4 (&acc)[2][2][4][2], const Unit& u, int wr, int wc, int fr, int fq) const {
        const int pn = u.pn, row0 = u.pm * BM + wr * 64 + fr;
        if (pn <= 2) {
            if (pn < 2 || wc < 2) {
                const bool isq = pn < 2;
                bf16_t* base = isq ? Q : Kb; const int ld = isq ? 512 : 128; const int hcol = (isq ? (4 * pn + wc) : wc) * 64 + 8 * fq;
                const float sc = isq ? (0.125f * LOG2E) : 1.0f;
#pragma unroll
                for (int ai = 0; ai < 2; ++ai)
#pragma unroll
                    for (int m = 0; m < 4; ++m) {
                        const int row = row0 + ai * HALF + m * 16;
                        const f32x4 c0 = *(const f32x4*)(cosT + (size_t)row * 32 + 8 * fq), c1 = *(const f32x4*)(cosT + (size_t)row * 32 + 8 * fq + 4);
                        const f32x4 s0 = *(const f32x4*)(sinT + (size_t)row * 32 + 8 * fq), s1 = *(const f32x4*)(sinT + (size_t)row * 32 + 8 * fq + 4);
                        const f32x4 a0 = acc[ai][0][m][0], a1 = acc[ai][0][m][1], b0 = acc[ai][1][m][0], b1 = acc[ai][1][m][1];
                        const f32x4 o10 = (a0 * c0 - b0 * s0) * sc, o11 = (a1 * c1 - b1 * s1) * sc, o20 = (b0 * c0 + a0 * s0) * sc, o21 = (b1 * c1 + a1 * s1) * sc;
                        bf16_t* p = base + (size_t)row * ld + hcol;
                        *(u32x4*)p = pack8(o10, o11); *(u32x4*)(p + 32) = pack8(o20, o21);
                        asm volatile("" ::: "memory");
                    }
            } else {
#pragma unroll
                for (int ai = 0; ai < 2; ++ai)
#pragma unroll
                    for (int m = 0; m < 4; ++m) {
                        const int row = row0 + ai * HALF + m * 16;
#pragma unroll
                        for (int bj = 0; bj < 2; ++bj) *(u32x4*)(Vb + (size_t)row * 128 + 64 * bj + 32 * (wc - 2) + 8 * fq) = pack8(acc[ai][bj][m][0], acc[ai][bj][m][1]);
                    }
            }
        } else if (pn <= 6) {
            const int hh = pn - 3, dcol = hh * 128 + wc * 32 + 8 * fq;
            float lb[2][4], omlb[2][4];
#pragma unroll
            for (int n = 0; n < 2; ++n) { const f32x4 l0 = *(const f32x4*)(lbl + dcol + 4 * n), l1 = *(const f32x4*)(lbl + 512 + dcol + 4 * n);
#pragma unroll
                for (int i = 0; i < 4; ++i) { const float e = __expf(l1[i] - l0[i]); lb[n][i] = 1.0f / (1.0f + e); omlb[n][i] = e / (1.0f + e); } }
#pragma unroll
            for (int ai = 0; ai < 2; ++ai) {
                float b2[4][2][4];
#pragma unroll
                for (int m = 0; m < 4; ++m)
#pragma unroll
                    for (int n = 0; n < 2; ++n)
#pragma unroll
                        for (int i = 0; i < 4; ++i) { const float hf = __builtin_fminf(__builtin_fmaxf(acc[ai][1][m][n][i], -30.f), 30.f);
                            const float f = lb[n][i] + omlb[n][i] * fast_sigmoid(hf); b2[m][n][i] = __builtin_amdgcn_logf(f); }
#pragma unroll
                for (int n = 0; n < 2; ++n)
#pragma unroll
                    for (int i = 0; i < 4; ++i) { float carry = 0.f;
#pragma unroll
                        for (int m = 0; m < 4; ++m) { const float P = row_incl_scan(b2[m][n][i]); const float T = __shfl(P, (int)((threadIdx.x & 63u) | 15u)); b2[m][n][i] = P + carry; carry += T; } }
#pragma unroll
                for (int m = 0; m < 4; ++m) {
                    const int row = row0 + ai * HALF + m * 16;
                    f32x4 qo[2], ko[2], eb[2];
#pragma unroll
                    for (int n = 0; n < 2; ++n)
#pragma unroll
                        for (int i = 0; i < 4; ++i) { const float hq = acc[ai][0][m][n][i]; float hf = acc[ai][1][m][n][i]; asm volatile("" : "+v"(hf)); hf = __builtin_fminf(__builtin_fmaxf(hf, -30.f), 30.f);
                            const float e = __builtin_amdgcn_exp2f(-LOG2E * hf), r = __builtin_amdgcn_rcpf(1.0f + e), kk = omlb[n][i] * (e * r);
                            const float q = fast_silu(hq) * 0.08838834764831845f, bb = b2[m][n][i], eb_ = __builtin_amdgcn_exp2f(bb);
                            qo[n][i] = q * eb_; ko[n][i] = kk * __builtin_amdgcn_exp2f(-bb); eb[n][i] = eb_; }
                    *(u32x4*)(QT + (size_t)row * 512 + dcol) = pack8(qo[0], qo[1]);
                    *(u32x4*)(KH + (size_t)row * 512 + dcol) = pack8(ko[0], ko[1]);
                    if (m == 3 && fr == 15) { float* ep = EBL + (size_t)(u.pm * 4 + 2 * ai + wr) * 512 + dcol; *(f32x4*)ep = eb[0]; *(f32x4*)(ep + 4) = eb[1]; }
                    asm volatile("" ::: "memory");
                }
            }
        } else {
            const bool isg = pn >= 9; bf16_t* base = isg ? GH : VH; const int tcol = (pn - (isg ? 9 : 7)) * 256 + wc * 32 + 8 * fq;
#pragma unroll
            for (int ai = 0; ai < 2; ++ai)
#pragma unroll
                for (int m = 0; m < 4; ++m) {
                    const int row = row0 + ai * HALF + m * 16;
#pragma unroll
                    for (int bj = 0; bj < 2; ++bj) { f32x4 v0 = acc[ai][bj][m][0], v1 = acc[ai][bj][m][1];
                        if (isg) {
#pragma unroll
                            for (int i = 0; i < 4; ++i) { v0[i] = fast_silu(v0[i]); v1[i] = fast_silu(v1[i]); } }
                        *(u32x4*)(base + (size_t)row * 512 + tcol + bj * HALF) = pack8(v0, v1); }
                }
        }
    }
};
template <class Epi, class Sched, bool ALIGN_EPI = false, bool SP2 = false>
__device__ __forceinline__ void gemm_phase(PG8_LAS unsigned char* lds, const Gemm g, const Sched& S, const Epi& E) {
    const int tid = threadIdx.x, wid = __builtin_amdgcn_readfirstlane(tid >> 6), lane = tid & 63, wr = wid >> 2, wc = wid & 3, fr = lane & 15, fq = lane >> 4;
    const int K = g.K, nt = K / BK;
    unsigned voffA[2], voffB[2];
#pragma unroll
    for (int i = 0; i < 2; ++i) { int R, C; stage_rc(tid * 16 + i * 8192, R, C); const int Rb = Epi::PERM ? ((R & ~31) + perm32(R & 31)) : R;
        voffA[i] = (unsigned)(R * K + C) * 2u; voffB[i] = (unsigned)(Rb * K + C) * 2u; }
    const size_t kstep = (size_t)(BK * 2);
    const size_t hstep = (size_t)HALF * K * 2;
    const size_t tstep = 2 * hstep;
    const unsigned ldsw = (unsigned)wid * 1024u;
    const int aoff = lds_byte(wr * 64 + fr, fq * 8), boff = lds_byte(wc * 32 + fr, fq * 8);
#define PG8_SA(b, h) (((b) * 2 + (h)) * HTB)
#define PG8_SB(b, h) ((4 + (b) * 2 + (h)) * HTB)
#define PG8_STAGE(bufoff, gbase, voff) do { _Pragma("unroll") for (int _i = 0; _i < 2; ++_i) \
        __builtin_amdgcn_global_load_lds((const unsigned*)((const char*)(gbase) + (voff)[_i]), (PG8_LAS unsigned*)(lds + (bufoff) + ldsw + _i * 8192), 16, 0, 0); } while (0)
#define PG8_LDA(dst, b, h) do { _Pragma("unroll") for (int m = 0; m < 4; ++m) _Pragma("unroll") for (int k = 0; k < 2; ++k) dst[m][k] = *(const PG8_LAS bf16x8*)(lds + PG8_SA(b, h) + aoff + m * 2048 + k * 1024); } while (0)
#define PG8_LDB(dst, b, h) do { _Pragma("unroll") for (int n = 0; n < 2; ++n) _Pragma("unroll") for (int k = 0; k < 2; ++k) dst[n][k] = *(const PG8_LAS bf16x8*)(lds + PG8_SB(b, h) + boff + n * 2048 + k * 1024); } while (0)
#define PG8_MMA(ai, bj, At, Bt) do { __builtin_amdgcn_s_setprio(1); _Pragma("unroll") for (int m = 0; m < 4; ++m) _Pragma("unroll") for (int n = 0; n < 2; ++n) _Pragma("unroll") for (int k = 0; k < 2; ++k) \
        acc[ai][bj][m][n] = __builtin_amdgcn_mfma_f32_16x16x32_bf16(Bt[n][k], At[m][k], acc[ai][bj][m][n], 0, 0, 0); __builtin_amdgcn_s_setprio(0); } while (0)
#define PG8_WAIT_V(n) asm volatile("s_waitcnt vmcnt(" #n ")" ::: "memory")
#define PG8_WAIT_L(n) asm volatile("s_waitcnt lgkmcnt(" #n ")" ::: "memory")
#define PG8_BAR __builtin_amdgcn_s_barrier()
#define PG8_SCHED __builtin_amdgcn_sched_barrier(0)
    Unit cur, nxt; int ui = 0;
    if (!S.next(0, cur)) return;
    f32x4 acc[2][2][4][2];
#pragma unroll
    for (int a = 0; a < 2; ++a)
#pragma unroll
        for (int b = 0; b < 2; ++b)
#pragma unroll
            for (int m = 0; m < 4; ++m)
#pragma unroll
                for (int n = 0; n < 2; ++n) acc[a][b][m][n] = (f32x4){0.f, 0.f, 0.f, 0.f};
    bf16x8 At[4][2], B0[2][2], B1[2][2];
    const char* cA = (const char*)g.A + (size_t)cur.pm * tstep; const char* cB = (const char*)g.Bt + (size_t)cur.pn * tstep;
    S.a_ready(cur);
    if constexpr (SP2) {
        PG8_STAGE(PG8_SB(0, 0), cB, voffB); PG8_STAGE(PG8_SB(0, 1), cB + hstep, voffB); PG8_STAGE(PG8_SA(0, 0), cA, voffA); PG8_STAGE(PG8_SA(0, 1), cA + hstep, voffA);
        if (wr == 1) PG8_BAR;
        PG8_WAIT_V(2); PG8_BAR;
        PG8_STAGE(PG8_SB(1, 0), cB + kstep, voffB); PG8_STAGE(PG8_SA(1, 0), cA + kstep, voffA); PG8_STAGE(PG8_SB(1, 1), cB + hstep + kstep, voffB);
        PG8_WAIT_V(6); PG8_BAR;
    } else {
        PG8_STAGE(PG8_SB(0, 0), cB, voffB); PG8_STAGE(PG8_SA(0, 0), cA, voffA); PG8_STAGE(PG8_SB(0, 1), cB + hstep, voffB); PG8_STAGE(PG8_SA(0, 1), cA + hstep, voffA);
        if (wr == 1) PG8_BAR;
        PG8_WAIT_V(4); PG8_BAR;
        PG8_STAGE(PG8_SB(1, 0), cB + kstep, voffB); PG8_STAGE(PG8_SA(1, 0), cA + kstep, voffA); PG8_STAGE(PG8_SB(1, 1), cB + hstep + kstep, voffB);
        PG8_WAIT_V(6); PG8_BAR;
    }
    for (;;) {
        const bool has_next = S.next(ui + 1, nxt);
        const char* nA = has_next ? (const char*)g.A + (size_t)nxt.pm * tstep : cA; const char* nB = has_next ? (const char*)g.Bt + (size_t)nxt.pn * tstep : cB;
        for (int t = 0; t < nt; t += 2) {
            const bool last = (t == nt - 2);
            const char* a1 = cA + (size_t)(t + 1) * kstep;
            const char* a2 = last ? nA : cA + (size_t)(t + 2) * kstep; const char* b2 = last ? nB : cB + (size_t)(t + 2) * kstep;
            const char* a3 = a2 + kstep; const char* b3 = b2 + kstep;
            if (last && has_next) S.a_ready(nxt);
            if constexpr (SP2) {
            PG8_LDB(B0, 0, 0); PG8_LDB(B1, 0, 1); PG8_SCHED; PG8_LDA(At, 0, 0); PG8_STAGE(PG8_SA(1, 1), a1 + hstep, voffA);
            PG8_WAIT_V(8); PG8_WAIT_L(0); PG8_BAR; PG8_MMA(0, 0, At, B0); PG8_MMA(0, 1, At, B1); PG8_BAR; PG8_SCHED;
            PG8_LDA(At, 0, 1); PG8_STAGE(PG8_SB(0, 0), b2, voffB); PG8_STAGE(PG8_SB(0, 1), b2 + hstep, voffB); PG8_STAGE(PG8_SA(0, 0), a2, voffA);
            PG8_WAIT_V(8); PG8_WAIT_L(0); PG8_BAR; PG8_MMA(1, 0, At, B0); PG8_MMA(1, 1, At, B1); PG8_BAR; PG8_SCHED;
            PG8_LDB(B0, 1, 0); PG8_LDB(B1, 1, 1); PG8_SCHED; PG8_LDA(At, 1, 0); PG8_STAGE(PG8_SA(0, 1), a2 + hstep, voffA);
            PG8_WAIT_V(8); PG8_WAIT_L(0); PG8_BAR; PG8_MMA(0, 0, At, B0); PG8_MMA(0, 1, At, B1); PG8_BAR; PG8_SCHED;
            PG8_LDA(At, 1, 1); PG8_STAGE(PG8_SB(1, 0), b3, voffB); PG8_STAGE(PG8_SB(1, 1), b3 + hstep, voffB); PG8_STAGE(PG8_SA(1, 0), a3, voffA);
            PG8_WAIT_V(8); PG8_WAIT_L(0); PG8_BAR; PG8_MMA(1, 0, At, B0); PG8_MMA(1, 1, At, B1); PG8_BAR; PG8_SCHED;
            } else {
            PG8_LDB(B0, 0, 0); PG8_SCHED; PG8_LDA(At, 0, 0); PG8_STAGE(PG8_SA(1, 1), a1 + hstep, voffA);
            PG8_WAIT_L(8); PG8_BAR; PG8_WAIT_L(0); PG8_MMA(0, 0, At, B0); PG8_BAR; PG8_SCHED;
            PG8_LDB(B1, 0, 1); PG8_STAGE(PG8_SB(0, 0), b2, voffB);
            PG8_BAR; PG8_WAIT_L(0); PG8_MMA(0, 1, At, B1); PG8_BAR;
            PG8_LDA(At, 0, 1); PG8_STAGE(PG8_SA(0, 0), a2, voffA);
            PG8_BAR; PG8_WAIT_L(0); PG8_MMA(1, 0, At, B0); PG8_BAR; PG8_SCHED;
            PG8_STAGE(PG8_SB(0, 1), b2 + hstep, voffB);
            PG8_WAIT_V(6); PG8_BAR; PG8_MMA(1, 1, At, B1); PG8_BAR;
            PG8_LDB(B0, 1, 0); PG8_SCHED; PG8_LDA(At, 1, 0); PG8_STAGE(PG8_SA(0, 1), a2 + hstep, voffA);
            PG8_WAIT_L(8); PG8_BAR; PG8_WAIT_L(0); PG8_MMA(0, 0, At, B0); PG8_BAR; PG8_SCHED;
            PG8_LDB(B1, 1, 1); PG8_STAGE(PG8_SB(1, 0), b3, voffB);
            PG8_BAR; PG8_WAIT_L(0); PG8_MMA(0, 1, At, B1); PG8_BAR;
            PG8_LDA(At, 1, 1); PG8_STAGE(PG8_SA(1, 0), a3, voffA);
            PG8_BAR; PG8_WAIT_L(0); PG8_MMA(1, 0, At, B0); PG8_BAR; PG8_SCHED;
            PG8_STAGE(PG8_SB(1, 1), b3 + hstep, voffB);
            PG8_WAIT_V(6); PG8_BAR; PG8_MMA(1, 1, At, B1); PG8_BAR;
            }
        }
        if constexpr (ALIGN_EPI) { if (wr == 0) PG8_BAR; }
        if constexpr (!Epi::AFTER_DRAIN) { E(acc, cur, wr, wc, fr, fq); S.done(cur); }
        if (!has_next) break;
#pragma unroll
        for (int a = 0; a < 2; ++a)
#pragma unroll
            for (int b = 0; b < 2; ++b)
#pragma unroll
                for (int m = 0; m < 4; ++m)
#pragma unroll
                    for (int n = 0; n < 2; ++n) acc[a][b][m][n] = (f32x4){0.f, 0.f, 0.f, 0.f};
        cur = nxt; cA = nA; cB = nB; ++ui;
        if constexpr (ALIGN_EPI) { if (wr == 1) PG8_BAR; }
    }
    PG8_WAIT_V(0);
    if constexpr (!ALIGN_EPI) { if (wr == 0) PG8_BAR; }
    PG8_BAR;
    if constexpr (Epi::AFTER_DRAIN) { E.fused(acc, cur, wr, wc, fr, fq, lds, wid, lane); S.done(cur); }
#undef PG8_SA
#undef PG8_SB
#undef PG8_STAGE
#undef PG8_LDA
#undef PG8_LDB
#undef PG8_MMA
#undef PG8_WAIT_V
#undef PG8_WAIT_L
#undef PG8_BAR
#undef PG8_SCHED
}
}
#define GAS __attribute__((address_space(1)))
#define LAS __attribute__((address_space(3)))
typedef unsigned short bf16;
typedef unsigned v4u __attribute__((ext_vector_type(4)));
typedef float f32x4 __attribute__((ext_vector_type(4)));
typedef short bf16x8 __attribute__((ext_vector_type(8)));
typedef GAS unsigned gu32;
typedef GAS unsigned long long gu64;
#define RLX_AGENT __ATOMIC_RELAXED, __HIP_MEMORY_SCOPE_AGENT
#define LDS_WAIT() asm volatile("s_waitcnt lgkmcnt(0)" ::: "memory")
#define VM_WAIT() asm volatile("s_waitcnt vmcnt(0)" ::: "memory")
__device__ __forceinline__ unsigned long long rt() { return __builtin_amdgcn_s_memrealtime(); }
__device__ __forceinline__ unsigned f2bf(float f) { unsigned u = __builtin_bit_cast(unsigned, f); return (u + 0x7fffu + ((u >> 16) & 1u)) >> 16; }
__device__ __forceinline__ unsigned pk2(float lo, float hi) { return f2bf(lo) | (f2bf(hi) << 16); }

#define XB_TMO      128
#define XB_XCNT(j)  (256  + 64 * (j))
#define XB_XSUB(j)  (1280 + 64 * (j))
#define XB_XGEN(j)  (2304 + 64 * (j))
#define XB_TOP      3328
#define XB_TOPGEN   3392
#define XCD_BAR_WORDS 3456
#define XB_SPIN_CAP (1u << 18)

__device__ __forceinline__ unsigned xb_ld(unsigned* p)              { return __hip_atomic_load(p, __ATOMIC_RELAXED, __HIP_MEMORY_SCOPE_AGENT); }
__device__ __forceinline__ unsigned xb_add(unsigned* p, unsigned v) { return __hip_atomic_fetch_add(p, v, __ATOMIC_RELAXED, __HIP_MEMORY_SCOPE_AGENT); }
__device__ __forceinline__ unsigned xb_xcc_id() { return (unsigned)__builtin_amdgcn_s_getreg((3 << 11) | 20) & 0xFu; }
#define XB_SPIN(cond, bar) do { unsigned _sp = 0; while (cond) { __builtin_amdgcn_s_sleep(1); \
    if ((++_sp & 255u) == 0u) { if (xb_ld(&(bar)[XB_TMO])) break; if (_sp > XB_SPIN_CAP) { atomicAdd(&(bar)[XB_TMO], 1u); break; } } } } while (0)

struct XcdBarrier {
    unsigned* bar; unsigned x;
    volatile LAS unsigned* st;
};

__device__ __forceinline__ XcdBarrier xcd_barrier_post(unsigned* bar, volatile LAS unsigned* st) {
    XcdBarrier b; b.bar = bar; b.x = xb_xcc_id(); b.st = st;
    if (threadIdx.x == 0) (void)xb_add(&bar[XB_XCNT(b.x)], 1u);
    return b;
}
__device__ __forceinline__ void xcd_barrier_complete(unsigned* bar, unsigned x, unsigned& nloc, unsigned& nx) {
    const unsigned G = gridDim.x * gridDim.y * gridDim.z;
    unsigned sum, cnt, mine, sp = 0u;
    for (;;) {
        sum = 0u; cnt = 0u; mine = 0u;
#pragma unroll
        for (unsigned j = 0; j < 16; ++j) { const unsigned c = xb_ld(&bar[XB_XCNT(j)]); sum += c; cnt += (c > 0u) ? 1u : 0u; mine = (j == x) ? c : mine; }
        if (sum == G) break;
        __builtin_amdgcn_s_sleep(1);
        if ((++sp & 255u) == 0u) { if (xb_ld(&bar[XB_TMO])) break; if (sp > XB_SPIN_CAP) { atomicAdd(&bar[XB_TMO], 1u); break; } }
    }
    nloc = mine > 0u ? mine : 1u; nx = cnt > 0u ? cnt : 1u;
}

__device__ __forceinline__ void xcd_barrier(const XcdBarrier& b) {
    asm volatile("s_waitcnt vmcnt(0)" ::: "memory");
    __syncthreads();
    if (threadIdx.x == 0) {
        unsigned* bar = b.bar;
        __builtin_amdgcn_s_waitcnt(0);
        unsigned nloc = b.st[0], nx = b.st[1];
        if (nloc == 0u) { xcd_barrier_complete(bar, b.x, nloc, nx); b.st[0] = nloc; b.st[1] = nx; }
        const unsigned old = xb_add(&bar[XB_XSUB(b.x)], 1u);
        const unsigned gen = old / nloc;
        if (old + 1u == (gen + 1u) * nloc) {
            __builtin_amdgcn_fence(__ATOMIC_RELEASE, "agent");
            asm volatile("s_waitcnt vmcnt(0)" ::: "memory");
            const unsigned og = xb_add(&bar[XB_TOP], 1u);
            const unsigned tg = og / nx;
            if (og + 1u == (tg + 1u) * nx) xb_add(&bar[XB_TOPGEN], 1u);
            else XB_SPIN(xb_ld(&bar[XB_TOPGEN]) == tg, bar);
            __builtin_amdgcn_fence(__ATOMIC_ACQUIRE, "agent");
            xb_add(&bar[XB_XGEN(b.x)], 1u);
            asm volatile("s_waitcnt vmcnt(0)" ::: "memory");
        } else {
            XB_SPIN(xb_ld(&bar[XB_XGEN(b.x)]) == gen, bar);
            __builtin_amdgcn_fence(__ATOMIC_ACQUIRE, "agent");
            asm volatile("s_waitcnt vmcnt(0)" ::: "memory");
        }
    }
    __syncthreads();
}

constexpr int NWAVES = 8;
constexpr int BATCH = 8, SEQ = 4096, D = 1024, M = BATCH * SEQ, FF = 2816, NPROJ = 2816, NMOD = 9 * D, CHUNK = 64;
constexpr float EPS = 1e-6f;
constexpr size_t MiB = 1u << 20;
constexpr size_t WS_CTL = 0, CTL_ZERO_BYTES = 1 * MiB;
constexpr size_t WS_W1A = 2 * MiB, WS_W1B = 13 * MiB, WS_W2A = 24 * MiB, WS_W2B = 30 * MiB, WS_WMI = 36 * MiB, WS_WMO = 42 * MiB;
constexpr size_t WS_MODP = 44 * MiB, WS_MOD = 47 * MiB, WS_COS = 48 * MiB, WS_SIN = 52 * MiB, WS_EBL = 56 * MiB;
constexpr size_t WS_H = 64 * MiB;
constexpr size_t WS_U = 128 * MiB;
constexpr size_t WS_Q = 128 * MiB, WS_K = 160 * MiB, WS_V = 168 * MiB, WS_QT = 176 * MiB, WS_KH = 208 * MiB, WS_VH = 240 * MiB, WS_GH = 272 * MiB;
constexpr size_t WS_Y = 304 * MiB, WS_HL = 432 * MiB, WS_HD = 448 * MiB, WS_END = 449 * MiB;
constexpr int CW_BAR = 4096;
constexpr int RING_OFF = 0, RING_BYTES = 131072, LDSCTL_OFF = RING_BYTES, MISC_OFF = LDSCTL_OFF + 320, LDS_BYTES = 147456;

struct Frame {
    LAS unsigned char* lds; volatile LAS unsigned* MISC; gu32* ctl;
    int tid, lane, wave, vcu, G;
};
struct Args { const void* in[14]; float* out; unsigned char* ws; int ph_lo, ph_hi; };

__device__ __forceinline__ float wave_sum(float v) {
#pragma unroll
    for (int o = 1; o < 64; o <<= 1) v += __shfl_xor(v, o);
    return v;
}
__device__ __forceinline__ float bf2f(unsigned short h) { return __builtin_bit_cast(float, (unsigned)h << 16); }

__device__ __forceinline__ void transpose_item(const float* W, int K, int N, bf16* WT, int k0, int nsrc0, int ndst0, LAS float* scr, int lane) {
#pragma unroll 8
    for (int i = 0; i < 32; ++i) { const int kk = 2 * i + (lane >> 5); scr[kk * 33 + (lane & 31)] = W[(size_t)(k0 + kk) * N + nsrc0 + (lane & 31)]; }
    LDS_WAIT(); asm volatile("" ::: "memory");
    const int c = lane & 7;
#pragma unroll
    for (int j = 0; j < 4; ++j) { const int n = (lane >> 3) + 8 * j; const LAS float* s = scr + (8 * c) * 33 + n;
        v4u o; o.x = pk2(s[0 * 33], s[1 * 33]); o.y = pk2(s[2 * 33], s[3 * 33]); o.z = pk2(s[4 * 33], s[5 * 33]); o.w = pk2(s[6 * 33], s[7 * 33]);
        *(GAS v4u*)(WT + (size_t)(ndst0 + n) * K + k0 + 8 * c) = o; }
    LDS_WAIT(); asm volatile("" ::: "memory");
}
__device__ __forceinline__ int mix_src_col(int np) {
    const int t = np >> 8, r = np & 255, bj = r >> 7, j = r & 127;
    if (t < 2) return (4 * t + (j >> 5)) * 64 + 32 * bj + (j & 31);
    if (t == 2) return j < 64 ? 512 + (j >> 5) * 64 + 32 * bj + (j & 31) : 640 + 64 * bj + (j - 64);
    if (t <= 6) return (bj ? 1280 : 768) + (t - 3) * 128 + j;
    return 1792 + (t - 7) * 256 + r;
}
__device__ __forceinline__ int swiglu_src_col(int np) { const int t = np >> 8, r = np & 255; return (r >= 128 ? FF : 0) + t * 128 + (r & 127); }

__device__ __forceinline__ void sincos_d(double a, double& s, double& c) {
    const double q = __builtin_rint(a * 0.63661977236758134308);
    double r = __builtin_fma(-q, 1.57079632673412561417e+00, a); r = __builtin_fma(-q, 6.07710050650619224932e-11, r);
    const double z = r * r;
    double ps = 1.0 / 6227020800.0; ps = __builtin_fma(ps, z, -1.0 / 39916800.0); ps = __builtin_fma(ps, z, 1.0 / 362880.0); ps = __builtin_fma(ps, z, -1.0 / 5040.0);
    ps = __builtin_fma(ps, z, 1.0 / 120.0); ps = __builtin_fma(ps, z, -1.0 / 6.0); ps = __builtin_fma(ps * z, r, r);
    double pc = -1.0 / 87178291200.0; pc = __builtin_fma(pc, z, 1.0 / 479001600.0); pc = __builtin_fma(pc, z, -1.0 / 3628800.0); pc = __builtin_fma(pc, z, 1.0 / 40320.0);
    pc = __builtin_fma(pc, z, -1.0 / 720.0); pc = __builtin_fma(pc, z, 1.0 / 24.0); pc = __builtin_fma(pc, z, -0.5); pc = __builtin_fma(pc, z, 1.0);
    const int qi = (int)q & 3;
    s = (qi == 0) ? ps : (qi == 1) ? pc : (qi == 2) ? -ps : -pc;
    c = (qi == 0) ? pc : (qi == 1) ? -ps : (qi == 2) ? -pc : ps;
}

struct Ptrs {
    const float *x, *c, *w_cond, *b_cond, *norm_pre, *norm_post, *ffn_w_in, *ffn_w_out, *w_mix_in, *w_mix_out, *sinks, *lbl, *gnorm; const int* pos;
    float* out; unsigned char* ws;
};

__device__ __forceinline__ void p0a(Frame& F, const Ptrs& P) {
    float* MODP = (float*)(P.ws + WS_MODP);
    for (int it = F.vcu; it < 256; it += F.G) {
        const int cb = it & 31, ks = it >> 5;
        LAS float* cact = (LAS float*)(F.lds); LAS float* red = cact + 1024;
        for (int i = F.tid; i < 1024; i += NWAVES * 64) { const float cv = P.c[(i >> 7) * D + ks * 128 + (i & 127)]; cact[i] = cv / (1.0f + __expf(-cv)); }
        __syncthreads();
        if (F.tid < 504) {
            const int col4 = F.tid % 72, kg = F.tid / 72;
            f32x4 a[8];
#pragma unroll
            for (int b = 0; b < 8; ++b) a[b] = (f32x4){0.f, 0.f, 0.f, 0.f};
            for (int k = kg; k < 128; k += 7) { const f32x4 w = *(const f32x4*)(P.w_cond + (size_t)(ks * 128 + k) * NMOD + cb * 288 + col4 * 4);
#pragma unroll
                for (int b = 0; b < 8; ++b) a[b] += w * cact[b * 128 + k]; }
#pragma unroll
            for (int b = 0; b < 8; ++b) *(LAS f32x4*)(red + (kg * 8 + b) * 288 + col4 * 4) = a[b];
        }
        __syncthreads();
        for (int i = F.tid; i < 8 * 288; i += NWAVES * 64) { const int b = i / 288, cc = i % 288; float s = 0.f;
#pragma unroll
            for (int kg = 0; kg < 7; ++kg) s += red[(kg * 8 + b) * 288 + cc];
            MODP[(size_t)(ks * 8 + b) * NMOD + cb * 288 + cc] = s; }
        __syncthreads();
    }
    {
        LAS float* scr = (LAS float*)(F.lds + RING_OFF + F.wave * 16384);
        const int gw = F.vcu * NWAVES + F.wave, NGW = F.G * NWAVES;
        constexpr int I_IN = (D / 64) * (2 * FF / 32), I_OUT = (FF / 64) * (D / 32), I_MI = (D / 64) * (NPROJ / 32), I_MO = (D / 64) * (D / 32);
        constexpr int NITEMS = 2 * I_IN + 2 * I_OUT + I_MI + I_MO;
        for (int it = gw; it < NITEMS; it += NGW) {
            int r = it;
            if (r < 2 * I_IN) { const int l = r / I_IN; r -= l * I_IN; const int nblk = 2 * FF / 32, kb = r / nblk, nb = r % nblk;
                transpose_item(P.ffn_w_in + (size_t)l * D * 2 * FF, D, 2 * FF, (bf16*)(P.ws + (l ? WS_W1B : WS_W1A)), 64 * kb, swiglu_src_col(32 * nb), 32 * nb, scr, F.lane); continue; }
            r -= 2 * I_IN;
            if (r < 2 * I_OUT) { const int l = r / I_OUT; r -= l * I_OUT; const int nblk = D / 32, kb = r / nblk, nb = r % nblk;
                transpose_item(P.ffn_w_out + (size_t)l * FF * D, FF, D, (bf16*)(P.ws + (l ? WS_W2B : WS_W2A)), 64 * kb, 32 * nb, 32 * nb, scr, F.lane); continue; }
            r -= 2 * I_OUT;
            if (r < I_MI) { const int nblk = NPROJ / 32, kb = r / nblk, nb = r % nblk;
                transpose_item(P.w_mix_in, D, NPROJ, (bf16*)(P.ws + WS_WMI), 64 * kb, mix_src_col(32 * nb), 32 * nb, scr, F.lane); continue; }
            r -= I_MI;
            { const int nblk = D / 32, kb = r / nblk, nb = r % nblk; transpose_item(P.w_mix_out, D, D, (bf16*)(P.ws + WS_WMO), 64 * kb, 32 * nb, 32 * nb, scr, F.lane); }
        }
    }
    {
        float* cosT = (float*)(P.ws + WS_COS); float* sinT = (float*)(P.ws + WS_SIN);
        const int gt = F.vcu * NWAVES * 64 + F.tid, NGT = F.G * NWAVES * 64;
        for (int idx = gt; idx < M * 32; idx += NGT) {
            const int k = idx & 31; double inv = 1.0, rr = 0.7498942093324559;
#pragma unroll
            for (int bit = 0; bit < 5; ++bit) { if (k & (1 << bit)) inv *= rr; rr *= rr; }
            double s, c; sincos_d((double)P.pos[idx >> 5] * inv, s, c);
            cosT[idx] = (float)c; sinT[idx] = (float)s;
        }
    }
}

template <bool FROM_PART> __device__ __forceinline__ float modval(const float* modsrc, const float* b_cond, int b, int oc) {
    if (FROM_PART) { float s = b_cond[oc];
#pragma unroll
        for (int ks = 0; ks < 8; ++ks) s += modsrc[(size_t)(ks * 8 + b) * NMOD + oc];
        return s; }
    return modsrc[(size_t)b * NMOD + oc];
}
template <bool HAS_Y, bool HAS_H, bool FROM_PART>
__device__ __forceinline__ void row_pass(Frame& F, const Ptrs& P, const float* xi, const float* y, float* xo, bf16* ho, const float* modsrc,
                                         int gt_off, const float* gpost, float resw, int sh_off, int sc_off, const float* gpre) {
    LAS float* Gc = (LAS float*)(F.lds); LAS float* Ac = Gc + D; LAS float* Bc = Ac + D;
    for (int rb = F.vcu; rb < M / 128; rb += F.G) {
        const int b = rb / (SEQ / 128);
        for (int col = F.tid; col < D; col += NWAVES * 64) {
            if (HAS_Y) Gc[col] = resw * modval<FROM_PART>(modsrc, P.b_cond, b, gt_off + col) * gpost[col];
            if (HAS_H) { Ac[col] = gpre[col] * (1.0f + modval<FROM_PART>(modsrc, P.b_cond, b, sc_off + col)); Bc[col] = modval<FROM_PART>(modsrc, P.b_cond, b, sh_off + col); }
        }
        __syncthreads();
        for (int rr = 0; rr < 128 / NWAVES; ++rr) {
            const size_t row = (size_t)rb * 128 + F.wave * (128 / NWAVES) + rr;
            const f32x4* xr = (const f32x4*)(xi + row * D) + F.lane;
            f32x4 v[4];
#pragma unroll
            for (int j = 0; j < 4; ++j) v[j] = xr[64 * j];
            if (HAS_Y) {
                const f32x4* yr = (const f32x4*)(y + row * D) + F.lane; f32x4 yv[4]; float s = 0.f;
#pragma unroll
                for (int j = 0; j < 4; ++j) { yv[j] = yr[64 * j]; s += (yv[j].x * yv[j].x + yv[j].y * yv[j].y) + (yv[j].z * yv[j].z + yv[j].w * yv[j].w); }
                const float r = 1.0f / sqrtf(wave_sum(s) * (1.0f / D) + EPS);
#pragma unroll
                for (int j = 0; j < 4; ++j) { const f32x4 g = *(const LAS f32x4*)(Gc + 256 * j + 4 * F.lane); v[j] += g * yv[j] * r; }
                f32x4* xw = (f32x4*)(xo + row * D) + F.lane;
#pragma unroll
                for (int j = 0; j < 4; ++j) xw[64 * j] = v[j];
            }
            if (HAS_H) {
                float s2 = 0.f;
#pragma unroll
                for (int j = 0; j < 4; ++j) s2 += (v[j].x * v[j].x + v[j].y * v[j].y) + (v[j].z * v[j].z + v[j].w * v[j].w);
                const float r2 = 1.0f / sqrtf(wave_sum(s2) * (1.0f / D) + EPS);
                unsigned long long* o8 = (unsigned long long*)(ho + row * D) + F.lane;
#pragma unroll
                for (int j = 0; j < 4; ++j) { const f32x4 a = *(const LAS f32x4*)(Ac + 256 * j + 4 * F.lane), bb = *(const LAS f32x4*)(Bc + 256 * j + 4 * F.lane);
                    const f32x4 h = v[j] * r2 * a + bb;
                    o8[64 * j] = (unsigned long long)pk2(h.x, h.y) | ((unsigned long long)pk2(h.z, h.w) << 32); }
            }
        }
        __syncthreads();
    }
}

__device__ __forceinline__ void p0b(Frame& F, const Ptrs& P) {
    const float* MODP = (const float*)(P.ws + WS_MODP); float* MOD = (float*)(P.ws + WS_MOD);
    for (int idx = F.vcu * NWAVES * 64 + F.tid; idx < BATCH * NMOD; idx += F.G * NWAVES * 64) {
        const int b = idx / NMOD, col = idx % NMOD; float s = P.b_cond[col];
#pragma unroll
        for (int ks = 0; ks < 8; ++ks) s += MODP[(size_t)(ks * 8 + b) * NMOD + col];
        MOD[idx] = s;
    }
    row_pass<false, true, true>(F, P, P.x, nullptr, nullptr, (bf16*)(P.ws + WS_H), MODP, 0, nullptr, 0.f, 0 * D, 1 * D, P.norm_pre + 0 * D);
}

__device__ __forceinline__ void attn_slow(Frame& F, const Ptrs& P) {
    const bf16* Q = (const bf16*)(P.ws + WS_Q); const bf16* K = (const bf16*)(P.ws + WS_K); const bf16* V = (const bf16*)(P.ws + WS_V); bf16* CAT = (bf16*)(P.ws + WS_H);
    const int gw = F.vcu * NWAVES + F.wave, NGW = F.G * NWAVES;
    for (int it = gw; it < BATCH * 64 * 8; it += NGW) {
        const int head = it & 7, n = (it >> 3) & 63, b = it >> 9, hk = head >> 2;
        const size_t row = (size_t)b * SEQ + n * CHUNK + F.lane;
        float q[64], o[64];
#pragma unroll
        for (int g = 0; g < 8; ++g) { const v4u w = *(const v4u*)(Q + row * 512 + head * 64 + 8 * g);
            q[8 * g + 0] = bf2f(w.x & 0xffff); q[8 * g + 1] = bf2f(w.x >> 16); q[8 * g + 2] = bf2f(w.y & 0xffff); q[8 * g + 3] = bf2f(w.y >> 16);
            q[8 * g + 4] = bf2f(w.z & 0xffff); q[8 * g + 5] = bf2f(w.z >> 16); q[8 * g + 6] = bf2f(w.w & 0xffff); q[8 * g + 7] = bf2f(w.w >> 16); }
#pragma unroll
        for (int d = 0; d < 64; ++d) o[d] = 0.f;
        float mx = P.sinks[head] * 1.4426950408889634f, l = 1.0f;
        const int j0 = (n >= 2 ? n - 2 : 0) * CHUNK, j1 = (n + 1) * CHUNK;
        for (int j = j0; j < j1; ++j) {
            int off = 0; asm volatile("" : "+v"(off));
            const bf16* kp = K + ((size_t)b * SEQ + j) * 128 + hk * 64 + off; const bf16* vp = V + ((size_t)b * SEQ + j) * 128 + hk * 64 + off;
            float s = 0.f;
#pragma unroll
            for (int g = 0; g < 8; ++g) { const v4u w = *(const v4u*)(kp + 8 * g);
                s += q[8 * g + 0] * bf2f(w.x & 0xffff) + q[8 * g + 1] * bf2f(w.x >> 16) + q[8 * g + 2] * bf2f(w.y & 0xffff) + q[8 * g + 3] * bf2f(w.y >> 16)
                   + q[8 * g + 4] * bf2f(w.z & 0xffff) + q[8 * g + 5] * bf2f(w.z >> 16) + q[8 * g + 6] * bf2f(w.w & 0xffff) + q[8 * g + 7] * bf2f(w.w >> 16); }
            const float mn = fmaxf(mx, s), a = exp2f(mx - mn), p = exp2f(s - mn);
            l = l * a + p; mx = mn;
#pragma unroll
            for (int g = 0; g < 8; ++g) { const v4u w = *(const v4u*)(vp + 8 * g);
                o[8 * g + 0] = o[8 * g + 0] * a + p * bf2f(w.x & 0xffff); o[8 * g + 1] = o[8 * g + 1] * a + p * bf2f(w.x >> 16);
                o[8 * g + 2] = o[8 * g + 2] * a + p * bf2f(w.y & 0xffff); o[8 * g + 3] = o[8 * g + 3] * a + p * bf2f(w.y >> 16);
                o[8 * g + 4] = o[8 * g + 4] * a + p * bf2f(w.z & 0xffff); o[8 * g + 5] = o[8 * g + 5] * a + p * bf2f(w.z >> 16);
                o[8 * g + 6] = o[8 * g + 6] * a + p * bf2f(w.w & 0xffff); o[8 * g + 7] = o[8 * g + 7] * a + p * bf2f(w.w >> 16); }
        }
        const float inv = 1.0f / l;
#pragma unroll
        for (int g = 0; g < 8; ++g) { v4u w; w.x = pk2(o[8 * g] * inv, o[8 * g + 1] * inv); w.y = pk2(o[8 * g + 2] * inv, o[8 * g + 3] * inv); w.z = pk2(o[8 * g + 4] * inv, o[8 * g + 5] * inv); w.w = pk2(o[8 * g + 6] * inv, o[8 * g + 7] * inv);
            *(v4u*)(CAT + row * D + head * 64 + 8 * g) = w; }
    }
}
__device__ __forceinline__ void hgrn_slow(Frame& F, const Ptrs& P) {
    const bf16* QT = (const bf16*)(P.ws + WS_QT); const bf16* KH = (const bf16*)(P.ws + WS_KH); const bf16* VH = (const bf16*)(P.ws + WS_VH); const bf16* GH = (const bf16*)(P.ws + WS_GH);
    const float* EBL = (const float*)(P.ws + WS_EBL); bf16* CAT = (bf16*)(P.ws + WS_H);
    LAS bf16* qL = (LAS bf16*)(F.lds); LAS bf16* kL = qL + 32 * 128; LAS bf16* vL = kL + 32 * 128; LAS float* part = (LAS float*)(F.lds + 32768);
    for (int it = F.vcu; it < BATCH * 4; it += F.G) {
        const int b = it >> 2, hh = it & 3, e = F.tid & 127, dq = F.tid >> 7;
        float R[32];
#pragma unroll
        for (int i = 0; i < 32; ++i) R[i] = 0.f;
        for (int c = 0; c < 64; ++c) {
            for (int half = 0; half < 2; ++half) {
                const size_t row0 = (size_t)b * SEQ + c * CHUNK + half * 32;
                { const int r = F.tid >> 4, ch = F.tid & 15; const size_t g = (row0 + r) * 512 + hh * 128 + ch * 8;
                  *(LAS v4u*)(qL + r * 128 + ch * 8) = *(const v4u*)(QT + g); *(LAS v4u*)(kL + r * 128 + ch * 8) = *(const v4u*)(KH + g); *(LAS v4u*)(vL + r * 128 + ch * 8) = *(const v4u*)(VH + g); }
                __syncthreads();
                for (int t = 0; t < 32; ++t) {
                    const float ve = bf2f(vL[t * 128 + e]); float partial = 0.f;
#pragma unroll
                    for (int g = 0; g < 4; ++g) { const v4u kw = *(const LAS v4u*)(kL + t * 128 + dq * 32 + 8 * g), qw = *(const LAS v4u*)(qL + t * 128 + dq * 32 + 8 * g);
                        const unsigned kk[4] = {kw.x, kw.y, kw.z, kw.w}, qq[4] = {qw.x, qw.y, qw.z, qw.w};
#pragma unroll
                        for (int p2 = 0; p2 < 4; ++p2) {
                            R[8 * g + 2 * p2] += bf2f(kk[p2] & 0xffff) * ve; partial += bf2f(qq[p2] & 0xffff) * R[8 * g + 2 * p2];
                            R[8 * g + 2 * p2 + 1] += bf2f(kk[p2] >> 16) * ve; partial += bf2f(qq[p2] >> 16) * R[8 * g + 2 * p2 + 1]; } }
                    part[(dq * 32 + t) * 128 + e] = partial;
                }
                __syncthreads();
                { const int t = F.tid >> 4, e8 = (F.tid & 15) * 8; float o[8]; float ss = 0.f;
#pragma unroll
                  for (int k = 0; k < 8; ++k) { o[k] = (part[(0 * 32 + t) * 128 + e8 + k] + part[(1 * 32 + t) * 128 + e8 + k]) + (part[(2 * 32 + t) * 128 + e8 + k] + part[(3 * 32 + t) * 128 + e8 + k]); ss += o[k] * o[k]; }
                  ss += __shfl_xor(ss, 1); ss += __shfl_xor(ss, 2); ss += __shfl_xor(ss, 4); ss += __shfl_xor(ss, 8);
                  const float r = 1.0f / sqrtf(ss * (1.0f / 128.0f) + EPS);
                  const v4u gw = *(const v4u*)(GH + (row0 + t) * 512 + hh * 128 + e8); const unsigned gg[4] = {gw.x, gw.y, gw.z, gw.w};
                  v4u w; unsigned ww[4];
#pragma unroll
                  for (int p2 = 0; p2 < 4; ++p2) ww[p2] = pk2(o[2 * p2] * r * P.gnorm[e8 + 2 * p2] * bf2f(gg[p2] & 0xffff), o[2 * p2 + 1] * r * P.gnorm[e8 + 2 * p2 + 1] * bf2f(gg[p2] >> 16));
                  w.x = ww[0]; w.y = ww[1]; w.z = ww[2]; w.w = ww[3];
                  *(v4u*)(CAT + (row0 + t) * D + 512 + hh * 128 + e8) = w; }
                __syncthreads();
            }
#pragma unroll
            for (int i = 0; i < 32; ++i) R[i] *= EBL[(size_t)(b * 64 + c) * 512 + hh * 128 + dq * 32 + i];
        }
    }
}

#ifndef MK_SLOW_MIX
#define MK_SLOW_MIX 0
#endif
namespace mixk {
typedef short bf16x8 __attribute__((ext_vector_type(8)));
typedef short s16x4 __attribute__((ext_vector_type(4)));
typedef float f32x16 __attribute__((ext_vector_type(16)));
typedef float f32x2_t __attribute__((ext_vector_type(2)));
typedef __bf16 bf16x2_t __attribute__((ext_vector_type(2)));
typedef LAS const char* lds_cptr;
__device__ __forceinline__ int crow(int r, int hi) { return (r & 3) + 8 * (r >> 2) + 4 * hi; }
__device__ __forceinline__ unsigned cvtpk(float lo, float hi) { f32x2_t v = {lo, hi}; bf16x2_t b = __builtin_convertvector(v, bf16x2_t); return __builtin_bit_cast(unsigned, b); }
__device__ __forceinline__ s16x4 vtr(lds_cptr p) { return __builtin_bit_cast(s16x4, __builtin_amdgcn_ds_read_tr16_b64_v4i16((LAS s16x4*)p)); }
__device__ __forceinline__ bf16x8 trfrag(lds_cptr p) { const s16x4 lo = vtr(p), hi = vtr(p + 512); return (bf16x8){lo[0], lo[1], lo[2], lo[3], hi[0], hi[1], hi[2], hi[3]}; }
__device__ __forceinline__ bf16x8 pack_frag(const f32x16& x, int k) {
    v4u w; w.x = cvtpk(x[8 * k + 0], x[8 * k + 1]); w.y = cvtpk(x[8 * k + 2], x[8 * k + 3]); w.z = cvtpk(x[8 * k + 4], x[8 * k + 5]); w.w = cvtpk(x[8 * k + 6], x[8 * k + 7]);
    return __builtin_bit_cast(bf16x8, w); }
__device__ __forceinline__ float swap_add(float v) { auto rr = __builtin_amdgcn_permlane32_swap(__float_as_uint(v), __float_as_uint(v), false, false); return __uint_as_float(rr[0]) + __uint_as_float(rr[1]); }
__device__ __forceinline__ float swap_max(float v) { auto rr = __builtin_amdgcn_permlane32_swap(__float_as_uint(v), __float_as_uint(v), false, false); return fmaxf(__uint_as_float(rr[0]), __uint_as_float(rr[1])); }
#define MFMA32(a, b, c) __builtin_amdgcn_mfma_f32_32x32x16_bf16((a), (b), (c), 0, 0, 0)

constexpr int A_K = 0, A_V = 24576, A_WS = 49152, A_OST = 51200;
__device__ __forceinline__ void attn_item(Frame& F, const Ptrs& P, int b, int n, int hk) {
    const bf16* Q = (const bf16*)(P.ws + WS_Q); const bf16* K = (const bf16*)(P.ws + WS_K); const bf16* V = (const bf16*)(P.ws + WS_V); bf16* CAT = (bf16*)(P.ws + WS_H);
    const int lane = F.lane, r32 = lane & 31, hi = lane >> 5, w = F.wave, head = 4 * hk + (w >> 1), th = w & 1;
    LAS unsigned char* lds = F.lds;
    v4u kreg[3], vreg[3];
#pragma unroll
    for (int t = 0; t < 3; ++t) { const int ci = n - 2 + t, cc = ci < 0 ? 0 : ci; const size_t kb_ = ((size_t)b * SEQ + cc * CHUNK) * 128 + hk * 64;
        kreg[t] = *(const v4u*)(K + kb_ + w * 8 + lane * 128);
        vreg[t] = *(const v4u*)(V + kb_ + (16 * (w & 3)) * 128 + (w >> 2) * 32 + ((lane >> 2) * 128 + (lane & 3) * 8)); }
    const size_t qrow0 = (size_t)b * SEQ + n * CHUNK + th * 32;
    bf16x8 qr[4];
#pragma unroll
    for (int d0 = 0; d0 < 4; ++d0) qr[d0] = *(const bf16x8*)(Q + qrow0 * 512 + head * 64 + (r32 * 512 + hi * 8) + d0 * 16);
#pragma unroll
    for (int t = 0; t < 3; ++t) { *(LAS v4u*)(lds + A_K + t * 8192 + w * 1024 + lane * 16) = kreg[t]; *(LAS v4u*)(lds + A_V + t * 8192 + w * 1024 + lane * 16) = vreg[t]; }
    __syncthreads();
    f32x16 p[3][2];
#pragma unroll
    for (int t = 0; t < 3; ++t) {
        const lds_cptr kb = (lds_cptr)(lds + A_K + t * 8192) + hi * 1024 + r32 * 16;
        f32x16 a0 = {}, a1 = {};
#pragma unroll
        for (int d0 = 0; d0 < 4; ++d0) { const bf16x8 k0 = *(const LAS bf16x8*)(kb + d0 * 2048), k1 = *(const LAS bf16x8*)(kb + d0 * 2048 + 512);
            a0 = MFMA32(k0, qr[d0], a0); a1 = MFMA32(k1, qr[d0], a1); }
        if (n - 2 + t < 0) {
#pragma unroll
            for (int r = 0; r < 16; ++r) { a0[r] = -1e30f; a1[r] = -1e30f; } }
        p[t][0] = a0; p[t][1] = a1;
    }
    const float sink2 = P.sinks[head] * 1.4426950408889634f;
    float mx = sink2;
#pragma unroll
    for (int t = 0; t < 3; ++t)
#pragma unroll
        for (int r = 0; r < 16; ++r) mx = fmaxf(mx, fmaxf(p[t][0][r], p[t][1][r]));
    mx = swap_max(mx);
    float l = 0.f;
#pragma unroll
    for (int t = 0; t < 3; ++t)
#pragma unroll
        for (int r = 0; r < 16; ++r) { p[t][0][r] = __builtin_amdgcn_exp2f(p[t][0][r] - mx); p[t][1][r] = __builtin_amdgcn_exp2f(p[t][1][r] - mx); l += p[t][0][r] + p[t][1][r]; }
    l = swap_add(l) + __builtin_amdgcn_exp2f(sink2 - mx);
    f32x16 o[2]; o[0] = f32x16{}; o[1] = f32x16{};
    const int trof = (4 * hi + ((lane & 15) >> 2)) * 64 + ((lane >> 4) & 1) * 32 + (lane & 3) * 8;
#pragma unroll
    for (int t = 0; t < 3; ++t) {
        const lds_cptr vp = (lds_cptr)(lds + A_V + t * 8192) + trof;
        const bf16x8 pa0 = pack_frag(p[t][0], 0), pa1 = pack_frag(p[t][0], 1), pa2 = pack_frag(p[t][1], 0), pa3 = pack_frag(p[t][1], 1);
#pragma unroll
        for (int d0 = 0; d0 < 2; ++d0) {
            o[d0] = MFMA32(pa0, trfrag(vp + d0 * 4096 + 0 * 1024), o[d0]); o[d0] = MFMA32(pa1, trfrag(vp + d0 * 4096 + 1 * 1024), o[d0]);
            o[d0] = MFMA32(pa2, trfrag(vp + d0 * 4096 + 2 * 1024), o[d0]); o[d0] = MFMA32(pa3, trfrag(vp + d0 * 4096 + 3 * 1024), o[d0]); }
    }
    LAS float* wsf = (LAS float*)(lds + A_WS) + w * 64;
    if (hi == 0) wsf[r32] = l;
    LDS_WAIT(); asm volatile("" ::: "memory");
    LAS bf16* stg = (LAS bf16*)(lds + A_OST) + w * 2048;
#pragma unroll
    for (int r = 0; r < 16; ++r) { const int orow = crow(r, hi); const float rl = __builtin_amdgcn_rcpf(wsf[orow]);
#pragma unroll
        for (int d0 = 0; d0 < 2; ++d0) stg[orow * 64 + d0 * 32 + r32] = (bf16)(cvtpk(o[d0][r] * rl, 0.f) & 0xffffu); }
    LDS_WAIT(); asm volatile("" ::: "memory");
#pragma unroll
    for (int i = 0; i < 4; ++i) { const int row = i * 8 + (lane >> 3), ch = lane & 7; const v4u v = *(const LAS v4u*)(stg + row * 64 + ch * 8);
        *(v4u*)(CAT + qrow0 * D + head * 64 + (row * D + ch * 8)) = v; }
    __syncthreads();
}

constexpr int NSEG = 8, CPS = 64 / NSEG;
constexpr int H_QL = 0, H_KA = 16384, H_KB = 32768, H_VL = 49152, H_ST = 65536, H_SSQ = 98304, H_EBL = 99328, H_GN = 99840;
template <bool MAIN>
__device__ __forceinline__ void hgrn_item(Frame& F, const Ptrs& P, int item) {
    const bf16* QT = (const bf16*)(P.ws + WS_QT); const bf16* KH = (const bf16*)(P.ws + WS_KH); const bf16* VH = (const bf16*)(P.ws + WS_VH); const bf16* GH = (const bf16*)(P.ws + WS_GH);
    const float* EBL = (const float*)(P.ws + WS_EBL); bf16* CAT = (bf16*)(P.ws + WS_H);
    float* HL = (float*)(P.ws + WS_HL); float* HD = (float*)(P.ws + WS_HD);
    const int seg = item % NSEG, bh = item / NSEG, hh = bh & 3, b = bh >> 2;
    const int lane = F.lane, r32 = lane & 31, hi = lane >> 5, w = F.wave, tid = F.tid;
    const int db = w >> 1, eb0 = 2 * (w & 1);
    const int tb = w >> 2, ebo = w & 3;
    LAS unsigned char* lds = F.lds;
    const int trof = (4 * hi + ((lane & 15) >> 2)) * 64 + ((lane >> 4) & 1) * 32 + (lane & 3) * 8;
    f32x16 S[2]; S[0] = f32x16{}; S[1] = f32x16{};
    float Dacc[16];
#pragma unroll
    for (int r = 0; r < 16; ++r) Dacc[r] = 1.0f;
    if (MAIN) {
        const int lofs = (4 * hi) * 128 + r32;
        for (int j = 0; j < seg; ++j) {
            const float* Lj = HL + ((size_t)bh * NSEG + j) * 16384 + (32 * db) * 128 + 32 * eb0; const float* Dj = HD + ((size_t)bh * NSEG + j) * 128 + 32 * db;
#pragma unroll
            for (int r = 0; r < 16; ++r) { const int dr = (r & 3) + 8 * (r >> 2); const float dj = Dj[dr + 4 * hi];
                S[0][r] = S[0][r] * dj + Lj[lofs + dr * 128]; S[1][r] = S[1][r] * dj + Lj[lofs + dr * 128 + 32]; }
        }
    }
    if (MAIN && tid < 128) ((LAS float*)(lds + H_GN))[tid] = P.gnorm[tid];
    v4u rq[2], rka[2], rkb[2], rv[2]; float rebl = 0.f;
    const int c0 = seg * CPS;
#define HG_STWRITE() do { _Pragma("unroll") for (int j_ = 0; j_ < 2; ++j_) _Pragma("unroll") for (int g_ = 0; g_ < 4; ++g_) { \
        const unsigned lo_ = cvtpk(S[j_][4 * g_], S[j_][4 * g_ + 1]), hi_ = cvtpk(S[j_][4 * g_ + 2], S[j_][4 * g_ + 3]); \
        *(LAS unsigned long long*)(lds + H_ST + (4 * db + g_) * 2048 + (32 * (eb0 + j_) + r32) * 16 + 8 * hi) = (unsigned long long)lo_ | ((unsigned long long)hi_ << 32); } } while (0)
    const int offq0 = (tid & 63) * 512 + (tid >> 6) * 8, offk0 = (16 * (w & 3) + (lane >> 2)) * 512 + 32 * (w >> 2) + 8 * (lane & 3);
#define HG_LOAD(c) do { const size_t rowc_ = ((size_t)b * SEQ + (size_t)(c) * CHUNK) * 512 + hh * 128; const bf16* q_ = QT + rowc_; const bf16* k_ = KH + rowc_; const bf16* v_ = VH + rowc_; \
        if (tid < 128) rebl = (EBL + (size_t)(b * 64 + (c)) * 512 + hh * 128)[tid]; \
        _Pragma("unroll") for (int i_ = 0; i_ < 2; ++i_) { \
            if (MAIN) { rq[i_] = *(const v4u*)(q_ + offq0 + 64 * i_); rka[i_] = *(const v4u*)(k_ + offq0 + 64 * i_); } \
            rkb[i_] = *(const v4u*)(k_ + offk0 + 64 * i_); rv[i_] = *(const v4u*)(v_ + offk0 + 64 * i_); } } while (0)
#define HG_WRITE() do { if (tid < 128) ((LAS float*)(lds + H_EBL))[tid] = rebl; _Pragma("unroll") for (int i_ = 0; i_ < 2; ++i_) { \
            if (MAIN) { const int dc_ = (tid >> 6) + 8 * i_; *(LAS v4u*)(lds + H_QL + dc_ * 1024 + (tid & 63) * 16) = rq[i_]; *(LAS v4u*)(lds + H_KA + dc_ * 1024 + (tid & 63) * 16) = rka[i_]; } \
            { const int pc_ = w + 8 * i_; *(LAS v4u*)(lds + H_KB + pc_ * 1024 + lane * 16) = rkb[i_]; *(LAS v4u*)(lds + H_VL + pc_ * 1024 + lane * 16) = rv[i_]; } } } while (0)
    HG_LOAD(c0);
    HG_WRITE();
    if (MAIN) HG_STWRITE();
    for (int c = c0; c < c0 + CPS; ++c) {
        __syncthreads();
        const size_t row0 = (size_t)b * SEQ + (size_t)c * CHUNK;
        if (c + 1 < c0 + CPS) HG_LOAD(c + 1);
        uint2 g4[4]; f32x16 oacc = {};
        if (MAIN) {
#pragma unroll
            for (int g = 0; g < 4; ++g) g4[g] = *(const uint2*)(GH + row0 * 512 + hh * 128 + 32 * ebo + (32 * tb) * 512 + (r32 * 512 + 4 * hi) + 8 * g);
            f32x16 X0 = {}, X1 = {};
#pragma unroll
            for (int kd = 0; kd < 8; ++kd) { const bf16x8 qf = *(const LAS bf16x8*)(lds + H_QL + (2 * kd + hi) * 1024 + (32 * tb + r32) * 16);
                oacc = MFMA32(*(const LAS bf16x8*)(lds + H_ST + (2 * kd + hi) * 2048 + (32 * ebo + r32) * 16), qf, oacc);
                X0 = MFMA32(*(const LAS bf16x8*)(lds + H_KA + (2 * kd + hi) * 1024 + r32 * 16), qf, X0);
                if (tb) X1 = MFMA32(*(const LAS bf16x8*)(lds + H_KA + (2 * kd + hi) * 1024 + (32 + r32) * 16), qf, X1); }
            if (tb == 0) {
#pragma unroll
                for (int r = 0; r < 16; ++r) X0[r] = (crow(r, hi) <= r32) ? X0[r] : 0.f;
            } else {
#pragma unroll
                for (int r = 0; r < 16; ++r) X1[r] = (crow(r, hi) <= r32) ? X1[r] : 0.f; }
            { const lds_cptr vp = (lds_cptr)(lds + H_VL) + ebo * 4096 + trof;
              oacc = MFMA32(trfrag(vp), pack_frag(X0, 0), oacc); oacc = MFMA32(trfrag(vp + 1024), pack_frag(X0, 1), oacc);
              if (tb) { oacc = MFMA32(trfrag(vp + 2048), pack_frag(X1, 0), oacc); oacc = MFMA32(trfrag(vp + 3072), pack_frag(X1, 1), oacc); } }
            float s = 0.f;
#pragma unroll
            for (int r = 0; r < 16; ++r) s += oacc[r] * oacc[r];
            s = swap_add(s);
            if (hi == 0) ((LAS float*)(lds + H_SSQ))[(tb * 4 + ebo) * 32 + r32] = s;
        }
        {
            const lds_cptr kp = (lds_cptr)(lds + H_KB) + db * 4096 + trof; const lds_cptr vp = (lds_cptr)(lds + H_VL) + eb0 * 4096 + trof;
#pragma unroll
            for (int ks = 0; ks < 4; ++ks) { const bf16x8 a = trfrag(kp + ks * 1024);
                S[0] = MFMA32(a, trfrag(vp + ks * 1024), S[0]); S[1] = MFMA32(a, trfrag(vp + 4096 + ks * 1024), S[1]); }
#pragma unroll
            for (int g = 0; g < 4; ++g) { const f32x4 e4 = *(const LAS f32x4*)(lds + H_EBL + (32 * db + 8 * g + 4 * hi) * 4);
#pragma unroll
                for (int i = 0; i < 4; ++i) { S[0][4 * g + i] *= e4[i]; S[1][4 * g + i] *= e4[i]; if (!MAIN) Dacc[4 * g + i] *= e4[i]; } }
        }
        __syncthreads();
        if (MAIN) {
            const LAS float* sq = (const LAS float*)(lds + H_SSQ) + tb * 128 + r32;
            const float tot = (sq[0] + sq[32]) + (sq[64] + sq[96]);
            const float rs = 1.0f / sqrtf(tot * (1.0f / 128.0f) + EPS);
#pragma unroll
            for (int g = 0; g < 4; ++g) {
                const f32x4 gn4 = *(const LAS f32x4*)(lds + H_GN + (32 * ebo + 8 * g + 4 * hi) * 4);
                const float o0 = oacc[4 * g] * rs * gn4[0] * bf2f((unsigned short)(g4[g].x & 0xffff)), o1 = oacc[4 * g + 1] * rs * gn4[1] * bf2f((unsigned short)(g4[g].x >> 16));
                const float o2 = oacc[4 * g + 2] * rs * gn4[2] * bf2f((unsigned short)(g4[g].y & 0xffff)), o3 = oacc[4 * g + 3] * rs * gn4[3] * bf2f((unsigned short)(g4[g].y >> 16));
                uint2 wv; wv.x = cvtpk(o0, o1); wv.y = cvtpk(o2, o3);
                *(uint2*)(CAT + (row0 + 32 * tb) * D + 512 + hh * 128 + 32 * ebo + (r32 * D + 4 * hi) + 8 * g) = wv; }
        }
        if (c + 1 < c0 + CPS) { HG_WRITE(); if (MAIN) HG_STWRITE(); }
    }
    if (!MAIN) {
        float* Lo = HL + ((size_t)bh * NSEG + seg) * 16384 + (32 * db) * 128 + 32 * eb0; float* Do = HD + ((size_t)bh * NSEG + seg) * 128 + 32 * db;
        const int lofs = (4 * hi) * 128 + r32;
#pragma unroll
        for (int r = 0; r < 16; ++r) { const int dr = (r & 3) + 8 * (r >> 2); Lo[lofs + dr * 128] = S[0][r]; Lo[lofs + dr * 128 + 32] = S[1][r];
            if ((w & 1) == 0 && r32 == 0) Do[dr + 4 * hi] = Dacc[r]; }
    }
    __syncthreads();
#undef HG_LOAD
#undef HG_STWRITE
#undef HG_WRITE
}
#undef MFMA32
}
__global__ void __launch_bounds__(NWAVES * 64, 2) mk_fwd(Args args) {
    extern __shared__ __attribute__((aligned(16))) unsigned char lds[];
    Frame F;
    F.lds = (LAS unsigned char*)lds; F.MISC = (volatile LAS unsigned*)(F.lds + MISC_OFF);
    F.tid = threadIdx.x; F.lane = F.tid & 63; F.wave = __builtin_amdgcn_readfirstlane(F.tid >> 6);
    F.G = gridDim.x; { const int bx = blockIdx.x; F.vcu = (F.G % 8 == 0) ? (bx % 8) * (F.G / 8) + bx / 8 : bx; }
    Ptrs P;
    P.x = (const float*)args.in[0]; P.c = (const float*)args.in[1]; P.pos = (const int*)args.in[2]; P.w_cond = (const float*)args.in[3]; P.b_cond = (const float*)args.in[4];
    P.norm_pre = (const float*)args.in[5]; P.norm_post = (const float*)args.in[6]; P.ffn_w_in = (const float*)args.in[7]; P.ffn_w_out = (const float*)args.in[8];
    P.w_mix_in = (const float*)args.in[9]; P.w_mix_out = (const float*)args.in[10]; P.sinks = (const float*)args.in[11]; P.lbl = (const float*)args.in[12]; P.gnorm = (const float*)args.in[13];
    P.out = args.out; P.ws = args.ws;
    F.ctl = (gu32*)(P.ws + WS_CTL);
    for (int u = F.tid; u < (LDS_BYTES - LDSCTL_OFF) / 4; u += NWAVES * 64) ((LAS unsigned*)(F.lds + LDSCTL_OFF))[u] = 0u;
    __syncthreads();
    const int lo = args.ph_lo, hi = args.ph_hi;
    const bool use_bar = (hi - lo) > 1;
    XcdBarrier bar; bar.bar = (unsigned*)(F.ctl + CW_BAR); bar.x = 0; bar.st = nullptr;
    if (use_bar) bar = xcd_barrier_post((unsigned*)(F.ctl + CW_BAR), F.MISC + 8);
#define IN(k) (lo <= (k) && (k) < hi)
#define SEAM(k) do { if (IN(k) && IN((k) + 1)) xcd_barrier(bar); } while (0)
    const float* MOD = (const float*)(P.ws + WS_MOD);
    bf16* HB = (bf16*)(P.ws + WS_H); bf16* UB = (bf16*)(P.ws + WS_U); float* YB = (float*)(P.ws + WS_Y);

    if (IN(0)) { p0a(F, P); } SEAM(0);
    if (IN(1)) { p0b(F, P); } SEAM(1);
    if (IN(2)) {
        pg8::Gemm g{HB, (const bf16*)(P.ws + WS_W1A), M, 2 * FF, D}; pg8::StaticOrder S; S.init(M, 2 * FF, F.G, (int)blockIdx.x);
        pg8::EpiSwiGLU E{UB, FF};
        pg8::gemm_phase<pg8::EpiSwiGLU, pg8::StaticOrder, true, true>(F.lds + RING_OFF, g, S, E);
    } SEAM(2);
    if (IN(3)) {
        pg8::Gemm g{UB, (const bf16*)(P.ws + WS_W2A), M, D, FF}; pg8::StaticOrder S; S.init(M, D, F.G, (int)blockIdx.x);
        pg8::EpiF32 E{YB, D};
        pg8::gemm_phase<pg8::EpiF32, pg8::StaticOrder, true, true>(F.lds + RING_OFF, g, S, E);
    } SEAM(3);
    if (IN(4)) {
        row_pass<true, true, false>(F, P, P.x, YB, P.out, HB, MOD, 2 * D, P.norm_post + 0 * D, 0.5f, 3 * D, 4 * D, P.norm_pre + 1 * D);
    } SEAM(4);
    if (IN(5)) {
        pg8::Gemm g{HB, (const bf16*)(P.ws + WS_WMI), M, NPROJ, D}; pg8::StaticOrder S; S.init(M, NPROJ, F.G, (int)blockIdx.x);
        pg8::EpiMix E{(bf16*)(P.ws + WS_Q), (bf16*)(P.ws + WS_K), (bf16*)(P.ws + WS_V), (bf16*)(P.ws + WS_QT), (bf16*)(P.ws + WS_KH), (bf16*)(P.ws + WS_VH), (bf16*)(P.ws + WS_GH),
                      (float*)(P.ws + WS_EBL), (const float*)(P.ws + WS_COS), (const float*)(P.ws + WS_SIN), P.lbl};
        pg8::gemm_phase<pg8::EpiMix, pg8::StaticOrder, true, true>(F.lds + RING_OFF, g, S, E);
    } SEAM(5);
    if (IN(6)) {
#if MK_SLOW_MIX
        hgrn_slow(F, P);
        attn_slow(F, P);
#else
        for (int it = F.vcu; it < BATCH * 4 * mixk::NSEG; it += F.G) if (it % mixk::NSEG != mixk::NSEG - 1) mixk::hgrn_item<false>(F, P, it);
        for (int it = F.vcu; it < BATCH * 64 * 2; it += F.G) mixk::attn_item(F, P, it >> 7, (it >> 1) & 63, it & 1);
#endif
    } SEAM(6);
    if (IN(7)) {
#if !MK_SLOW_MIX
        for (int it = F.vcu; it < BATCH * 4 * mixk::NSEG; it += F.G) mixk::hgrn_item<true>(F, P, it);
#endif
    } SEAM(7);
    if (IN(8)) {
        pg8::Gemm g{HB, (const bf16*)(P.ws + WS_WMO), M, D, D}; pg8::StaticOrder S; S.init(M, D, F.G, (int)blockIdx.x);
        pg8::EpiF32 E{YB, D};
        pg8::gemm_phase<pg8::EpiF32, pg8::StaticOrder, true, true>(F.lds + RING_OFF, g, S, E);
    } SEAM(8);
    if (IN(9)) {
        row_pass<true, true, false>(F, P, P.out, YB, P.out, HB, MOD, 5 * D, P.norm_post + 1 * D, 1.0f, 6 * D, 7 * D, P.norm_pre + 2 * D);
    } SEAM(9);
    if (IN(10)) {
        pg8::Gemm g{HB, (const bf16*)(P.ws + WS_W1B), M, 2 * FF, D}; pg8::StaticOrder S; S.init(M, 2 * FF, F.G, (int)blockIdx.x);
        pg8::EpiSwiGLU E{UB, FF};
        pg8::gemm_phase<pg8::EpiSwiGLU, pg8::StaticOrder, true, true>(F.lds + RING_OFF, g, S, E);
    } SEAM(10);
    if (IN(11)) {
        pg8::Gemm g{UB, (const bf16*)(P.ws + WS_W2B), M, D, FF}; pg8::StaticOrder S; S.init(M, D, F.G, (int)blockIdx.x);
        pg8::EpiF32 E{YB, D};
        pg8::gemm_phase<pg8::EpiF32, pg8::StaticOrder, true, true>(F.lds + RING_OFF, g, S, E);
    } SEAM(11);
    if (IN(12)) {
        row_pass<true, false, false>(F, P, P.out, YB, P.out, nullptr, MOD, 8 * D, P.norm_post + 2 * D, 0.5f, 0, 0, nullptr);
    }
#undef IN
#undef SEAM
}

constexpr int N_PHASES = 13;
#ifndef MK_SINGLE
#define MK_SINGLE 1
#endif
extern "C" void kernel_launch(void* const* d_in, const int* in_sizes, int n_in, void* d_out, int out_size, void* d_ws, size_t ws_size, hipStream_t stream) {
    static int grid = 0;
    if (grid == 0) {
        if (n_in != 14 || in_sizes[0] != M * D || out_size != M * D || ws_size < WS_END) { fprintf(stderr, "kernel_launch: unexpected shapes (n_in %d, in0 %d, out %d, ws %zu); nothing launched\n", n_in, n_in > 0 ? in_sizes[0] : -1, out_size, ws_size); grid = -1; return; }
        int dev = 0, cus = 0;
        if (hipGetDevice(&dev) != hipSuccess || hipDeviceGetAttribute(&cus, hipDeviceAttributeMultiprocessorCount, dev) != hipSuccess) { grid = -1; return; }
        if (hipFuncSetAttribute((const void*)mk_fwd, hipFuncAttributeMaxDynamicSharedMemorySize, LDS_BYTES) != hipSuccess) { fprintf(stderr, "kernel_launch: hipFuncSetAttribute failed\n"); grid = -1; return; }
        int per_cu = 0;
        if (hipOccupancyMaxActiveBlocksPerMultiprocessor(&per_cu, (const void*)mk_fwd, NWAVES * 64, LDS_BYTES) != hipSuccess || per_cu < 1) fprintf(stderr, "kernel_launch: occupancy query reports %d blocks per CU\n", per_cu);
        (void)hipGetLastError();
        grid = cus;
    }
    if (grid < 0) return;
    if (hipMemsetAsync((char*)d_ws + WS_CTL, 0, CTL_ZERO_BYTES, stream) != hipSuccess) return;
    Args a{};
    for (int i = 0; i < 14; ++i) a.in[i] = d_in[i];
    a.out = (float*)d_out; a.ws = (unsigned char*)d_ws;
#if MK_SINGLE
    a.ph_lo = 0; a.ph_hi = N_PHASES;
    hipLaunchKernelGGL(mk_fwd, dim3(grid), dim3(NWAVES * 64), LDS_BYTES, stream, a);
#else
    for (int p = 0; p < N_PHASES; ++p) { a.ph_lo = p; a.ph_hi = p + 1; hipLaunchKernelGGL(mk_fwd, dim3(grid), dim3(NWAVES * 64), LDS_BYTES, stream, a); }
#endif
}
```
